# Optimizing an MI355X kernel written in HIP

```python
import math
import jax, jax.numpy as jnp
from jax import lax
import numpy as np

D_MODEL = 1024
BATCH = 8
SEQ = 2048
DEPTH = 1

CHUNK = 64
D_MIX = D_MODEL
D_SSM = D_MIX // 2
SSM_GROUP = 16
N_SSM_GROUPS = D_SSM // SSM_GROUP
SSM_STATE = 64
D_CONV = D_MIX - D_SSM
CONV_WIDTH = 31
D_IN_PROJ = D_SSM + 2 * D_CONV
PEER_HEADS = 8
PEER_KEYS = 128
PEER_EXPERTS = PEER_KEYS * PEER_KEYS
PEER_TOPK = 16
PEER_DKEY = 256
PEER_HALF = PEER_DKEY // 2
PEER_BLOCK = 128
EPS = 1e-6
DT_MIN = 0.001
DT_MAX = 0.1

kernel_name = "hybrid_s5_conformer_peer_block"


def rmsnorm(x, g):
    xf = x.astype(jnp.float32)
    out = xf * lax.rsqrt(jnp.mean(xf * xf, axis=-1, keepdims=True) + EPS) * g.astype(jnp.float32)
    return out.astype(x.dtype)


def s5_mixer(u, lam_re, lam_im, log_dt, b_re, b_im, c_re, c_im, d_skip, glu_w, glu_b):
    bsz, seq, _ = u.shape
    f32 = jnp.float32
    ug = u.astype(f32).reshape(bsz, seq, N_SSM_GROUPS, SSM_GROUP)
    lr = lam_re.astype(f32)
    li = lam_im.astype(f32)
    dt = jnp.exp(log_dt.astype(f32))[:, None]
    mag = jnp.exp(lr * dt)
    ang = li * dt
    lb_re = mag * jnp.cos(ang)
    lb_im = mag * jnp.sin(ang)
    num_re = lb_re - 1.0
    num_im = lb_im
    den = lr * lr + li * li
    f_re = (num_re * lr + num_im * li) / den
    f_im = (num_im * lr - num_re * li) / den
    br = b_re.astype(f32)
    bi = b_im.astype(f32)
    bb_re = f_re[..., None] * br - f_im[..., None] * bi
    bb_im = f_re[..., None] * bi + f_im[..., None] * br
    bu_re = jnp.einsum('blgh,gph->blgp', ug, bb_re)
    bu_im = jnp.einsum('blgh,gph->blgp', ug, bb_im)
    a_re = jnp.broadcast_to(lb_re[None, None], (1, seq, N_SSM_GROUPS, SSM_STATE))
    a_im = jnp.broadcast_to(lb_im[None, None], (1, seq, N_SSM_GROUPS, SSM_STATE))

    def combine(e1, e2):
        a1r, a1i, b1r, b1i = e1
        a2r, a2i, b2r, b2i = e2
        return (a1r * a2r - a1i * a2i,
                a1r * a2i + a1i * a2r,
                a2r * b1r - a2i * b1i + b2r,
                a2r * b1i + a2i * b1r + b2i)

    _, _, s_re, s_im = lax.associative_scan(combine, (a_re, a_im, bu_re, bu_im), axis=1)
    y = (jnp.einsum('blgp,ghp->blgh', s_re, c_re.astype(f32))
         - jnp.einsum('blgp,ghp->blgh', s_im, c_im.astype(f32))
         + d_skip.astype(f32).reshape(N_SSM_GROUPS, SSM_GROUP) * ug)
    y = jax.nn.gelu(y, approximate=False)
    gate = jnp.einsum('blgh,ghk->blgk', y, glu_w.astype(f32)) + glu_b.astype(f32).reshape(N_SSM_GROUPS, SSM_GROUP)
    y = y * jax.nn.sigmoid(gate)
    return y.reshape(bsz, seq, D_SSM).astype(u.dtype)


def conformer_conv(v, g, conv_w, conv_b, ln_g, ln_b):
    h = v * jax.nn.sigmoid(g)
    h = lax.conv_general_dilated(
        h, conv_w[:, None, :], window_strides=(1,), padding=[(CONV_WIDTH - 1, 0)],
        dimension_numbers=('NWC', 'WIO', 'NWC'), feature_group_count=D_CONV) + conv_b
    hf = h.astype(jnp.float32)
    mu = jnp.mean(hf, axis=-1, keepdims=True)
    var = jnp.mean(jnp.square(hf - mu), axis=-1, keepdims=True)
    hn = (hf - mu) * lax.rsqrt(var + EPS) * ln_g.astype(jnp.float32) + ln_b.astype(jnp.float32)
    return jax.nn.silu(hn).astype(v.dtype)


def peer_ffn(xn, w_q, sub_k1, sub_k2, u_tab, v_tab):
    bsz, seq, d = xn.shape
    xt = xn.reshape(-1, PEER_BLOCK, d)
    k1 = sub_k1.astype(jnp.float32)
    k2 = sub_k2.astype(jnp.float32)

    def block(xb):
        q = (xb @ w_q).astype(jnp.float32).reshape(PEER_BLOCK, PEER_HEADS, 2, PEER_HALF)
        s1 = jnp.einsum('thk,nk->thn', q[:, :, 0], k1)
        s2 = jnp.einsum('thk,nk->thn', q[:, :, 1], k2)
        v1, i1 = lax.top_k(s1, PEER_TOPK)
        v2, i2 = lax.top_k(s2, PEER_TOPK)
        cand = (v1[..., :, None] + v2[..., None, :]).reshape(PEER_BLOCK, PEER_HEADS, PEER_TOPK * PEER_TOPK)
        sc, ci = lax.top_k(cand, PEER_TOPK)
        e1 = jnp.take_along_axis(i1, ci // PEER_TOPK, axis=-1)
        e2 = jnp.take_along_axis(i2, ci % PEER_TOPK, axis=-1)
        eid = e1 * PEER_KEYS + e2
        gates = jax.nn.softmax(sc, axis=-1)
        u_sel = u_tab[eid]
        act = jax.nn.gelu(jnp.einsum('td,thkd->thk', xb, u_sel).astype(jnp.float32), approximate=False)
        w = (gates * act).astype(xb.dtype)
        return jnp.einsum('thk,thkd->td', w, v_tab[eid])

    out = lax.map(block, xt)
    return out.reshape(bsz, seq, d)


def setup_inputs(seed: int = 0) -> dict:
    key = jax.random.key(seed)
    ks = jax.random.split(key, 24)
    f32 = jnp.float32
    nrm = lambda k, shape, s: (jax.random.normal(k, shape, f32) * s).astype(f32)
    L_, G, P, H = DEPTH, N_SSM_GROUPS, SSM_STATE, SSM_GROUP
    x = jax.random.normal(ks[0], (BATCH, SEQ, D_MODEL), f32)
    norm1_g = 1.0 + nrm(ks[1], (L_, D_MODEL), 0.02)
    w_in = nrm(ks[2], (L_, D_MODEL, D_IN_PROJ), D_MODEL ** -0.5)
    lam_re = -0.5 + nrm(ks[3], (L_, G, P), 0.01)
    lam_im = math.pi * jnp.arange(P, dtype=f32)[None, None, :] + nrm(ks[4], (L_, G, P), 0.01)
    log_dt = jax.random.uniform(ks[5], (L_, G), f32, math.log(DT_MIN), math.log(DT_MAX))
    ssm_b_re = nrm(ks[6], (L_, G, P, H), (2.0 * H) ** -0.5)
    ssm_b_im = nrm(ks[7], (L_, G, P, H), (2.0 * H) ** -0.5)
    ssm_c_re = nrm(ks[8], (L_, G, H, P), (2.0 * P) ** -0.5)
    ssm_c_im = nrm(ks[9], (L_, G, H, P), (2.0 * P) ** -0.5)
    ssm_d = nrm(ks[10], (L_, D_SSM), 1.0)
    glu_w = nrm(ks[11], (L_, G, H, H), H ** -0.5)
    glu_b = nrm(ks[12], (L_, D_SSM), 0.02)
    conv_w = nrm(ks[13], (L_, CONV_WIDTH, D_CONV), CONV_WIDTH ** -0.5)
    conv_b = nrm(ks[14], (L_, D_CONV), 0.02)
    conv_ln_g = 1.0 + nrm(ks[15], (L_, D_CONV), 0.02)
    conv_ln_b = nrm(ks[16], (L_, D_CONV), 0.02)
    w_out = nrm(ks[17], (L_, D_MIX, D_MODEL), D_MIX ** -0.5)
    norm2_g = 1.0 + nrm(ks[18], (L_, D_MODEL), 0.02)
    peer_wq = nrm(ks[19], (L_, D_MODEL, PEER_HEADS * PEER_DKEY), D_MODEL ** -0.5)
    peer_k1 = nrm(ks[20], (L_, PEER_KEYS, PEER_HALF), PEER_HALF ** -0.5)
    peer_k2 = nrm(ks[21], (L_, PEER_KEYS, PEER_HALF), PEER_HALF ** -0.5)
    peer_u = nrm(ks[22], (L_, PEER_EXPERTS, D_MODEL), D_MODEL ** -0.5)
    kv, kf = jax.random.split(ks[23])
    peer_v = nrm(kv, (L_, PEER_EXPERTS, D_MODEL), 0.5)
    final_g = 1.0 + nrm(kf, (D_MODEL,), 0.02)
    return {"x": x, "norm1_g": norm1_g, "w_in": w_in, "lam_re": lam_re, "lam_im": lam_im,
            "log_dt": log_dt, "ssm_b_re": ssm_b_re, "ssm_b_im": ssm_b_im, "ssm_c_re": ssm_c_re,
            "ssm_c_im": ssm_c_im, "ssm_d": ssm_d, "glu_w": glu_w, "glu_b": glu_b,
            "conv_w": conv_w, "conv_b": conv_b, "conv_ln_g": conv_ln_g, "conv_ln_b": conv_ln_b,
            "w_out": w_out, "norm2_g": norm2_g, "peer_wq": peer_wq, "peer_k1": peer_k1,
            "peer_k2": peer_k2, "peer_u": peer_u, "peer_v": peer_v, "final_g": final_g}


def reference(x, norm1_g, w_in, lam_re, lam_im, log_dt, ssm_b_re, ssm_b_im, ssm_c_re, ssm_c_im,
              ssm_d, glu_w, glu_b, conv_w, conv_b, conv_ln_g, conv_ln_b, w_out, norm2_g,
              peer_wq, peer_k1, peer_k2, peer_u, peer_v, final_g):
    for l in range(DEPTH):
        h = rmsnorm(x, norm1_g[l])
        z = h @ w_in[l]
        u_ssm = z[..., :D_SSM]
        v_conv = z[..., D_SSM:D_SSM + D_CONV]
        g_conv = z[..., D_SSM + D_CONV:]
        y_ssm = s5_mixer(u_ssm, lam_re[l], lam_im[l], log_dt[l], ssm_b_re[l], ssm_b_im[l],
                         ssm_c_re[l], ssm_c_im[l], ssm_d[l], glu_w[l], glu_b[l])
        y_conv = conformer_conv(v_conv, g_conv, conv_w[l], conv_b[l], conv_ln_g[l], conv_ln_b[l])
        x = x + jnp.concatenate([y_ssm, y_conv], axis=-1) @ w_out[l]
        x = x + peer_ffn(rmsnorm(x, norm2_g[l]), peer_wq[l], peer_k1[l], peer_k2[l], peer_u[l], peer_v[l])
    return rmsnorm(x, final_g)
```

```cpp
#include <hip/hip_runtime.h>
#include <hip/hip_cooperative_groups.h>
#include <cstdio>
#include <cstdint>

#define LAS __attribute__((address_space(3)))
typedef unsigned short bf16_t;
typedef short bf16x8 __attribute__((ext_vector_type(8)));
typedef float f32x4 __attribute__((ext_vector_type(4)));
typedef float f32x2 __attribute__((ext_vector_type(2)));
typedef unsigned u32x4 __attribute__((ext_vector_type(4)));
typedef unsigned u32x2 __attribute__((ext_vector_type(2)));
typedef int i32x2 __attribute__((ext_vector_type(2)));
typedef int i32x4 __attribute__((ext_vector_type(4)));
typedef int i32x8 __attribute__((ext_vector_type(8)));
typedef __bf16 bf16x2_t __attribute__((ext_vector_type(2)));

constexpr int NTOK = 16384, DM = 1024, SEQ = 2048;
constexpr int NG = 32, GH = 16, NP = 64, CHK = 16, NCH = NTOK / CHK  , KX = 384  ;
constexpr int NQ = 2048, NEXP = 16384;
constexpr float EPS = 1e-6f;
constexpr int NWAVES = 8, NTHR = 512;
constexpr int LDS_BYTES = 163840;

constexpr size_t MiB = 1u << 20;
constexpr size_t WS_CTL = 0;
constexpr size_t WS_WIN = 1 * MiB;
constexpr size_t WS_WOUT = 4 * MiB;
constexpr size_t WS_WQ = 6 * MiB;
constexpr size_t WS_KEXT = 10 * MiB;
constexpr size_t WS_W1EXT = 16 * MiB;
constexpr size_t WS_KBLK = 20 * MiB;
constexpr size_t WS_LPOW = 20 * MiB + 128 * 1024;
constexpr size_t WS_RSTD1 = 20 * MiB + 192 * 1024;
constexpr size_t WS_PAR = 20 * MiB + 256 * 1024;
constexpr int PO_CW = 0, PO_CB = 31 * 512, PO_LNG = PO_CB + 512, PO_LNB = PO_LNG + 512, PO_GLUW = PO_LNB + 512, PO_GLUB = PO_GLUW + 8192, PO_G2 = PO_GLUB + 512, PO_FG = PO_G2 + 1024, PO_END = PO_FG + 1024;
constexpr size_t WS_SSQ2 = 21 * MiB;
constexpr size_t WS_SELE = 22 * MiB;
constexpr size_t WS_SELG = 30 * MiB;
constexpr size_t WS_UTAB = 38 * MiB;
constexpr size_t WS_VTAB = 54 * MiB;
constexpr size_t WS_EXPU = 70 * MiB;
constexpr size_t WS_EXPV = 70 * MiB + 65536;
constexpr size_t WS_XB = 102 * MiB;
constexpr size_t WS_UEXT = 134 * MiB;
constexpr size_t WS_HCONV = 158 * MiB;
constexpr size_t WS_YCAT = 174 * MiB;
constexpr size_t WS_WQK = 206 * MiB;
constexpr size_t WS_END = 210 * MiB;

__device__ __forceinline__ unsigned cvt_pk_bf16(float lo, float hi) { unsigned r; asm volatile("v_cvt_pk_bf16_f32 %0, %1, %2" : "=v"(r) : "v"(lo), "v"(hi)); return r; }
__device__ __forceinline__ unsigned cvt_pk_bf16_c(float lo, float hi) { const f32x2 v = {lo, hi}; const bf16x2_t b = __builtin_convertvector(v, bf16x2_t); return __builtin_bit_cast(unsigned, b); }
__device__ __forceinline__ unsigned f2bf(float f) { unsigned u = __builtin_bit_cast(unsigned, f); return (u + 0x7fffu + ((u >> 16) & 1u)) >> 16; }
__device__ __forceinline__ float bf2f(unsigned b) { return __builtin_bit_cast(float, b << 16); }
__device__ __forceinline__ float wave_sum(float v) {
#pragma unroll
    for (int o = 1; o < 64; o <<= 1) v += __shfl_xor(v, o);
    return v;
}
template <int CTRL> __device__ __forceinline__ float dpp_f(float x) { return __builtin_bit_cast(float, __builtin_amdgcn_update_dpp(0, __builtin_bit_cast(int, x), CTRL, 0xf, 0xf, true)); }
__device__ __forceinline__ float wave_sum_dpp(float v) {
    v += dpp_f<0xB1>(v); v += dpp_f<0x4E>(v); v += dpp_f<0x141>(v); v += dpp_f<0x140>(v);
    v += __builtin_bit_cast(float, __builtin_amdgcn_update_dpp(0, __builtin_bit_cast(int, v), 0x142, 0xa, 0xf, false));
    v += __builtin_bit_cast(float, __builtin_amdgcn_update_dpp(0, __builtin_bit_cast(int, v), 0x143, 0xc, 0xf, false));
    return __builtin_bit_cast(float, __builtin_amdgcn_readlane(__builtin_bit_cast(int, v), 63));
}
__device__ __forceinline__ float wave_max_dpp(float v) {
    v = fmaxf(v, dpp_f<0xB1>(v)); v = fmaxf(v, dpp_f<0x4E>(v)); v = fmaxf(v, dpp_f<0x141>(v)); v = fmaxf(v, dpp_f<0x140>(v));
    v = fmaxf(v, __builtin_bit_cast(float, __builtin_amdgcn_update_dpp(0, __builtin_bit_cast(int, v), 0x142, 0xa, 0xf, false)));
    v = fmaxf(v, __builtin_bit_cast(float, __builtin_amdgcn_update_dpp(0, __builtin_bit_cast(int, v), 0x143, 0xc, 0xf, false)));
    return __builtin_bit_cast(float, __builtin_amdgcn_readlane(__builtin_bit_cast(int, v), 63));
}
__device__ __forceinline__ float sigmoidf_(float x) { return __builtin_amdgcn_rcpf(1.0f + __expf(-x)); }
__device__ __forceinline__ f32x2 gelu_pk(f32x2 v) {
    const f32x2 av = __builtin_elementwise_abs(v), d = av * 0.2316418882f + 1.0f;
    f32x2 t; t.x = __builtin_amdgcn_rcpf(d.x); t.y = __builtin_amdgcn_rcpf(d.y);
    f32x2 q = t * 0.5307027145f + (-0.7265760135f); q = q * t + 0.7107068705f; q = q * t + (-0.142248368f); q = q * t + 0.127414796f; q = q * t;
    const f32x2 s = (v * v) * (-0.72134752044f);
    f32x2 e; e.x = __builtin_amdgcn_exp2f(s.x); e.y = __builtin_amdgcn_exp2f(s.y);
    const f32x2 m = v * (q * e), r = v - m;
    f32x2 o; o.x = v.x < 0.f ? m.x : r.x; o.y = v.y < 0.f ? m.y : r.y; return o;
}
__device__ __forceinline__ float gelu1(float x) { f32x2 r = gelu_pk((f32x2){x, x}); return r.x; }
__device__ __forceinline__ float dot2_bf16(unsigned w, unsigned x, float acc) { return __builtin_amdgcn_fdot2_f32_bf16(__builtin_bit_cast(bf16x2_t, w), __builtin_bit_cast(bf16x2_t, x), acc, false); }
template <int S> __device__ __forceinline__ float ror16f(float x) { return __builtin_bit_cast(float, __builtin_amdgcn_update_dpp(0, __builtin_bit_cast(int, x), 0x120 + S, 0xf, 0xf, false)); }
template <int S> __device__ __forceinline__ int ror16i(int x) { return __builtin_amdgcn_update_dpp(0, x, 0x120 + S, 0xf, 0xf, false); }
__device__ __forceinline__ int lane_id_() { return (int)__builtin_amdgcn_mbcnt_hi(~0u, __builtin_amdgcn_mbcnt_lo(~0u, 0u)); }
#define LDS_WAIT() asm volatile("s_waitcnt lgkmcnt(0)" ::: "memory")
#define VM_WAIT() asm volatile("s_waitcnt vmcnt(0)" ::: "memory")

namespace pg8 {
constexpr int BM = 256, BK = 64, HALF = 128, HTB = HALF * BK * 2, STAGE_BYTES = 8 * HTB;
__host__ __device__ __forceinline__ int lds_byte(int r, int c) { const int st = (r >> 4) * 2 + (c >> 5), rr = r & 15, cc = c & 31, ob = rr * 64 + cc * 2; return st * 1024 + (ob ^ (((ob >> 9) & 1) << 5)); }
__host__ __device__ __forceinline__ void stage_rc(int b, int& R, int& C) { const int st = b / 1024, sb = b % 1024, swz = sb ^ (((sb >> 9) & 1) << 5); R = (st >> 1) * 16 + swz / 64; C = (st & 1) * 32 + (swz % 64) / 2; }
__host__ __device__ __forceinline__ int perm32(int rho) { const int n = rho >> 4, i = rho & 15; return 8 * (i >> 2) + 4 * n + (i & 3); }

struct Unit { const char* A; const char* B; int pm, pn; };
struct Gemm { int K, lda, ldb; };

template <class Epi, class Sched, bool ALIGN_EPI>
__device__ __forceinline__ void gemm_phase(LAS unsigned char* lds, const Gemm g, const Sched& S, const Epi& E, const int wave0) {
    int tid = (wave0 << 6) | lane_id_(); asm volatile("" : "+v"(tid));
    const int wid = __builtin_amdgcn_readfirstlane(tid >> 6), lane = tid & 63, wr = wid >> 2, wc = wid & 3, fr = lane & 15, fq = lane >> 4;
    const int K = g.K, nt = K / BK;
    unsigned voffA[2], voffB[2];
#pragma unroll
    for (int i = 0; i < 2; ++i) { int R, C; stage_rc(tid * 16 + i * 8192, R, C); const int Rb = Epi::PERM ? ((R & ~31) + perm32(R & 31)) : R;
        voffA[i] = (unsigned)(R * g.lda + C) * 2u; voffB[i] = (unsigned)(Rb * g.ldb + C) * 2u; }
    const size_t kstep = (size_t)(BK * 2);
    const size_t hstepA = (size_t)HALF * g.lda * 2, hstepB = (size_t)HALF * g.ldb * 2;
    const unsigned ldsw = (unsigned)wid * 1024u;
    const int aoff = lds_byte(wr * 64 + fr, fq * 8), boff = lds_byte(wc * 32 + fr, fq * 8);
#define PG8_SA(b, h) (((b) * 2 + (h)) * HTB)
#define PG8_SB(b, h) ((4 + (b) * 2 + (h)) * HTB)
#define PG8_STAGE(bufoff, gbase, voff) do { _Pragma("unroll") for (int _i = 0; _i < 2; ++_i) \
        __builtin_amdgcn_global_load_lds((const unsigned*)((const char*)(gbase) + (voff)[_i]), (LAS unsigned*)(lds + (bufoff) + ldsw + _i * 8192), 16, 0, 0); } while (0)
#define PG8_LDA(dst, b, h) do { _Pragma("unroll") for (int m = 0; m < 4; ++m) _Pragma("unroll") for (int k = 0; k < 2; ++k) dst[m][k] = *(const LAS bf16x8*)(lds + PG8_SA(b, h) + aoff + m * 2048 + k * 1024); } while (0)
#define PG8_LDB(dst, b, h) do { _Pragma("unroll") for (int n = 0; n < 2; ++n) _Pragma("unroll") for (int k = 0; k < 2; ++k) dst[n][k] = *(const LAS bf16x8*)(lds + PG8_SB(b, h) + boff + n * 2048 + k * 1024); } while (0)
#define PG8_MMA(ai, bj, At, Bt) do { __builtin_amdgcn_s_setprio(1); _Pragma("unroll") for (int m = 0; m < 4; ++m) _Pragma("unroll") for (int n = 0; n < 2; ++n) _Pragma("unroll") for (int k = 0; k < 2; ++k) \
        acc[ai][bj][m][n] = __builtin_amdgcn_mfma_f32_16x16x32_bf16(Bt[n][k], At[m][k], acc[ai][bj][m][n], 0, 0, 0); __builtin_amdgcn_s_setprio(0); } while (0)
#define PG8_WAIT_V(n) asm volatile("s_waitcnt vmcnt(" #n ")" ::: "memory")
#define PG8_WAIT_L(n) asm volatile("s_waitcnt lgkmcnt(" #n ")" ::: "memory")
#define PG8_BAR __builtin_amdgcn_s_barrier()
#define PG8_SCHED __builtin_amdgcn_sched_barrier(0)
    Unit cur, nxt; int ui = 0;
    if (!S.next(0, cur)) return;
    f32x4 acc[2][2][4][2];
#pragma unroll
    for (int a = 0; a < 2; ++a)
#pragma unroll
        for (int b = 0; b < 2; ++b)
#pragma unroll
            for (int m = 0; m < 4; ++m)
#pragma unroll
                for (int n = 0; n < 2; ++n) acc[a][b][m][n] = (f32x4){0.f, 0.f, 0.f, 0.f};
    bf16x8 At[4][2], B0[2][2], B1[2][2];
    const char* cA = cur.A; const char* cB = cur.B;
    PG8_STAGE(PG8_SB(0, 0), cB, voffB); PG8_STAGE(PG8_SB(0, 1), cB + hstepB, voffB); PG8_STAGE(PG8_SA(0, 0), cA, voffA); PG8_STAGE(PG8_SA(0, 1), cA + hstepA, voffA);
    if (wr == 1) PG8_BAR;
    PG8_WAIT_V(2); PG8_BAR;
    PG8_STAGE(PG8_SB(1, 0), cB + kstep, voffB); PG8_STAGE(PG8_SA(1, 0), cA + kstep, voffA); PG8_STAGE(PG8_SB(1, 1), cB + hstepB + kstep, voffB);
    PG8_WAIT_V(6); PG8_BAR;
    for (;;) {
        const bool has_next = S.next(ui + 1, nxt);
        const char* nA = has_next ? nxt.A : cA; const char* nB = has_next ? nxt.B : cB;
        for (int t = 0; t < nt; t += 2) {
            const bool last = (t == nt - 2);
            const char* a1 = cA + (size_t)(t + 1) * kstep;
            const char* a2 = last ? nA : cA + (size_t)(t + 2) * kstep; const char* b2 = last ? nB : cB + (size_t)(t + 2) * kstep;
            const char* a3 = a2 + kstep; const char* b3 = b2 + kstep;
            PG8_LDB(B0, 0, 0); PG8_LDB(B1, 0, 1); PG8_SCHED; PG8_LDA(At, 0, 0); PG8_STAGE(PG8_SA(1, 1), a1 + hstepA, voffA);
            PG8_WAIT_V(8); PG8_WAIT_L(0); PG8_BAR; PG8_MMA(0, 0, At, B0); PG8_MMA(0, 1, At, B1); PG8_BAR; PG8_SCHED;
            PG8_LDA(At, 0, 1); PG8_STAGE(PG8_SB(0, 0), b2, voffB); PG8_STAGE(PG8_SB(0, 1), b2 + hstepB, voffB); PG8_STAGE(PG8_SA(0, 0), a2, voffA);
            PG8_WAIT_V(8); PG8_WAIT_L(0); PG8_BAR; PG8_MMA(1, 0, At, B0); PG8_MMA(1, 1, At, B1); PG8_BAR; PG8_SCHED;
            PG8_LDB(B0, 1, 0); PG8_LDB(B1, 1, 1); PG8_SCHED; PG8_LDA(At, 1, 0); PG8_STAGE(PG8_SA(0, 1), a2 + hstepA, voffA);
            PG8_WAIT_V(8); PG8_WAIT_L(0); PG8_BAR; PG8_MMA(0, 0, At, B0); PG8_MMA(0, 1, At, B1); PG8_BAR; PG8_SCHED;
            PG8_LDA(At, 1, 1); PG8_STAGE(PG8_SB(1, 0), b3, voffB); PG8_STAGE(PG8_SB(1, 1), b3 + hstepB, voffB); PG8_STAGE(PG8_SA(1, 0), a3, voffA);
            PG8_WAIT_V(8); PG8_WAIT_L(0); PG8_BAR; PG8_MMA(1, 0, At, B0); PG8_MMA(1, 1, At, B1); PG8_BAR; PG8_SCHED;
        }
        if constexpr (ALIGN_EPI) { if (wr == 0) PG8_BAR; }
        if constexpr (!Epi::AFTER_DRAIN) { E(acc, cur, wr, wc, fr, fq); }
        if (!has_next) break;
#pragma unroll
        for (int a = 0; a < 2; ++a)
#pragma unroll
            for (int b = 0; b < 2; ++b)
#pragma unroll
                for (int m = 0; m < 4; ++m)
#pragma unroll
                    for (int n = 0; n < 2; ++n) acc[a][b][m][n] = (f32x4){0.f, 0.f, 0.f, 0.f};
        cur = nxt; cA = nA; cB = nB; ++ui;
        if constexpr (ALIGN_EPI) { if (wr == 1) PG8_BAR; }
    }
    PG8_WAIT_V(0);
    if constexpr (!ALIGN_EPI) { if (wr == 0) PG8_BAR; }
    PG8_BAR;
    if constexpr (Epi::AFTER_DRAIN) { E.fused(acc, cur, wr, wc, fr, fq, lds, wid, lane); }
#undef PG8_SA
#undef PG8_SB
#undef PG8_STAGE
#undef PG8_LDA
#undef PG8_LDB
#undef PG8_MMA
#undef PG8_WAIT_V
#undef PG8_WAIT_L
#undef PG8_BAR
#undef PG8_SCHED
}

struct GridOrder {
    const char* A; const char* B; size_t astep, bstep; int nM, nN, nwg, G, c;
    __device__ void init(const void* A_, const void* B_, int lda, int ldb, int M, int N, int G_, int c_) { A = (const char*)A_; B = (const char*)B_; astep = (size_t)BM * lda * 2; bstep = (size_t)BM * ldb * 2; nM = M / BM; nN = N / BM; nwg = nM * nN; G = G_; c = c_; }
    __device__ bool next(int i, Unit& u) const {
        const long L = (long)i * G + c; if (L >= nwg) return false;
        int wgid = (int)L; { const int q = nwg / 8, r = nwg % 8, xcd = wgid % 8, off = wgid / 8; wgid = (xcd < r ? xcd * (q + 1) : r * (q + 1) + (xcd - r) * q) + off; }
        const int nig = 8 * nN, gid = wgid / nig, fm = gid * 8, gsz = (nM - fm) < 8 ? (nM - fm) : 8;
        u.pm = fm + ((wgid % nig) % gsz); u.pn = (wgid % nig) / gsz; u.A = A + (size_t)u.pm * astep; u.B = B + (size_t)u.pn * bstep; return true;
    }
};
struct OneUnit {
    Unit u; int valid;
    __device__ bool next(int i, Unit& o) const { if (i == 0 && valid) { o = u; return true; } return false; }
};
}

struct EpiP1 {
    static constexpr bool PERM = true, AFTER_DRAIN = false;
    const float* rstd; bf16_t* uext; bf16_t* hconv;
    __device__ __forceinline__ void operator()(const f32x4 (&acc)[2][2][4][2], const pg8::Unit& u, int wr, int wc, int fr, int fq) const {
        asm volatile("" : "+v"(fr), "+v"(fq));
        const int row0 = u.pm * 256 + wr * 64 + fr;
        if (u.pn < 2) {
#pragma unroll
            for (int ai = 0; ai < 2; ++ai)
#pragma unroll
                for (int m = 0; m < 4; ++m) { const int row = row0 + ai * 128 + m * 16; const float rs = rstd[row]; const int ch = row >> 4, j = row & 15;
#pragma unroll
                    for (int bj = 0; bj < 2; ++bj) { const int g = 16 * u.pn + 8 * bj + 2 * wc + (fq >> 1);
                        const f32x4 v0 = acc[ai][bj][m][0] * rs, v1 = acc[ai][bj][m][1] * rs;
                        u32x4 w; w.x = cvt_pk_bf16(v0[0], v0[1]); w.y = cvt_pk_bf16(v0[2], v0[3]); w.z = cvt_pk_bf16(v1[0], v1[1]); w.w = cvt_pk_bf16(v1[2], v1[3]);
                        *(u32x4*)(uext + ((size_t)(g * NCH + ch)) * KX + j * 16 + 8 * (fq & 1)) = w; } }
        } else {
            const int q = u.pn - 2;
#pragma unroll
            for (int ai = 0; ai < 2; ++ai)
#pragma unroll
                for (int m = 0; m < 4; ++m) { const int row = row0 + ai * 128 + m * 16; const float rs = rstd[row];
                    float h[8];
#pragma unroll
                    for (int n = 0; n < 2; ++n)
#pragma unroll
                        for (int i = 0; i < 4; ++i) { const float v = acc[ai][0][m][n][i] * rs, gt = acc[ai][1][m][n][i] * rs; h[n * 4 + i] = v * sigmoidf_(gt); }
                    u32x4 w; w.x = cvt_pk_bf16(h[0], h[1]); w.y = cvt_pk_bf16(h[2], h[3]); w.z = cvt_pk_bf16(h[4], h[5]); w.w = cvt_pk_bf16(h[6], h[7]);
                    *(u32x4*)(hconv + (size_t)row * 512 + 128 * q + 32 * wc + 8 * fq) = w; }
        }
    }
};

struct EpiScan {
    static constexpr bool PERM = false, AFTER_DRAIN = true;
    const float* lpow; bf16_t* uext; int g, pn;
    __device__ __forceinline__ void fused(const f32x4 (&acc)[2][2][4][2], const pg8::Unit&, int wr, int wc, int fr, int fq, LAS unsigned char* lds, int wid, int lane) const {
        asm volatile("" : "+v"(fr), "+v"(fq), "+v"(lane));
        LAS float* SL = (LAS float*)lds;
        LAS f32x2* XE = (LAS f32x2*)(lds + 131072);
#pragma unroll
        for (int bj = 0; bj < 2; ++bj)
#pragma unroll
            for (int m = 0; m < 4; ++m)
#pragma unroll
                for (int n = 0; n < 2; ++n)
#pragma unroll
                    for (int i = 0; i < 4; ++i) { const int r = 64 * wr + 16 * m + fr, c = 128 * bj + 32 * wc + 16 * n + 4 * fq + i; SL[c * 128 + r] = acc[0][bj][m][n][i]; }
        LDS_WAIT(); __builtin_amdgcn_s_barrier(); asm volatile("" ::: "memory");
        const int p = lane, seg = wid & 3, bb = wid >> 2, c0 = 128 * bb + 32 * seg;
        const f32x4 lp = *(const f32x4*)(lpow + (size_t)(g * 64 + p) * 4);
        float er = 0.f, ei = 0.f;
        for (int i = 0; i < 32; ++i) { const float sr = SL[(c0 + i) * 128 + p], si = SL[(c0 + i) * 128 + 64 + p];
            const float nr = lp.x * er - lp.y * ei + sr, ni = lp.x * ei + lp.y * er + si; er = nr; ei = ni; }
        XE[(bb * 4 + seg) * 64 + p] = (f32x2){er, ei};
        LDS_WAIT(); __builtin_amdgcn_s_barrier(); asm volatile("" ::: "memory");
        float sr_ = 0.f, si_ = 0.f;
        for (int s = 0; s < 3; ++s) if (s < seg) { const f32x2 e = XE[(bb * 4 + s) * 64 + p]; const float nr = lp.z * sr_ - lp.w * si_ + e.x, ni = lp.z * si_ + lp.w * sr_ + e.y; sr_ = nr; si_ = ni; }
        for (int i = 0; i < 32; ++i) { const int chunk = 256 * pn + c0 + i; bf16_t* dst = uext + ((size_t)(g * NCH + chunk)) * KX;
            dst[256 + p] = (bf16_t)f2bf(sr_); dst[320 + p] = (bf16_t)f2bf(si_);
            const float lr = SL[(c0 + i) * 128 + p], li = SL[(c0 + i) * 128 + 64 + p];
            const float nr = lp.x * sr_ - lp.y * si_ + lr, ni = lp.x * si_ + lp.y * sr_ + li; sr_ = nr; si_ = ni; }
    }
};

typedef short s16x4 __attribute__((ext_vector_type(4)));
struct EpiGlu {
    static constexpr bool PERM = false, AFTER_DRAIN = false;
    const float* glu_w; const float* glu_b; bf16_t* ycat; int g, pn;
    __device__ __forceinline__ void operator()(const f32x4 (&acc)[2][2][4][2], const pg8::Unit&, int wr, int wc, int fr, int fq) const {
        asm volatile("" : "+v"(fr), "+v"(fq));
        const float* gw = glu_w + g * 256;
        s16x4 wa;
        { const unsigned p0 = cvt_pk_bf16_c(gw[(4 * fq + 0) * 16 + fr], gw[(4 * fq + 1) * 16 + fr]), p1 = cvt_pk_bf16_c(gw[(4 * fq + 2) * 16 + fr], gw[(4 * fq + 3) * 16 + fr]);
          wa[0] = (short)(p0 & 0xFFFFu); wa[1] = (short)(p0 >> 16); wa[2] = (short)(p1 & 0xFFFFu); wa[3] = (short)(p1 >> 16); }
        const f32x4 b4 = *(const f32x4*)(glu_b + g * 16 + 4 * fq);
#pragma unroll
        for (int ai = 0; ai < 2; ++ai)
#pragma unroll
            for (int m = 0; m < 4; ++m) { const int chunk = 256 * pn + 128 * ai + 64 * wr + 16 * m + fr;
#pragma unroll
                for (int bj = 0; bj < 2; ++bj)
#pragma unroll
                    for (int n = 0; n < 2; ++n) {
                        const f32x4 a = acc[ai][bj][m][n];
                        const f32x2 y01 = gelu_pk((f32x2){a[0], a[1]}), y23 = gelu_pk((f32x2){a[2], a[3]});
                        const unsigned q0 = cvt_pk_bf16_c(y01.x, y01.y), q1 = cvt_pk_bf16_c(y23.x, y23.y);
                        s16x4 yb; yb[0] = (short)(q0 & 0xFFFFu); yb[1] = (short)(q0 >> 16); yb[2] = (short)(q1 & 0xFFFFu); yb[3] = (short)(q1 >> 16);
                        const f32x4 gt = __builtin_amdgcn_mfma_f32_16x16x16bf16_1k(wa, yb, b4, 0, 0, 0);
                        const float o0 = y01.x * sigmoidf_(gt[0]), o1 = y01.y * sigmoidf_(gt[1]), o2 = y23.x * sigmoidf_(gt[2]), o3 = y23.y * sigmoidf_(gt[3]);
                        const int j = 8 * bj + 2 * wc + n, t = chunk * 16 + j;
                        u32x2 w; w.x = cvt_pk_bf16(o0, o1); w.y = cvt_pk_bf16(o2, o3);
                        *(u32x2*)(ycat + (size_t)t * DM + g * 16 + 4 * fq) = w;
                    } }
    }
};

struct EpiRes {
    static constexpr bool PERM = false, AFTER_DRAIN = false;
    const float* x; float* x1; bf16_t* xb1; float* ssq;
    __device__ __forceinline__ void operator()(const f32x4 (&acc)[2][2][4][2], const pg8::Unit& u, int wr, int wc, int fr, int fq) const {
        asm volatile("" : "+v"(fr), "+v"(fq));
        const int row0 = u.pm * 256 + wr * 64 + fr, col0 = u.pn * 256 + wc * 32 + 4 * fq;
#pragma unroll
        for (int ai = 0; ai < 2; ++ai)
#pragma unroll
            for (int m = 0; m < 4; ++m) { const int row = row0 + ai * 128 + m * 16; float s = 0.f;
#pragma unroll
                for (int bj = 0; bj < 2; ++bj)
#pragma unroll
                    for (int n = 0; n < 2; ++n) { const size_t off = (size_t)row * DM + col0 + bj * 128 + n * 16;
                        const u32x2 xq = *(const u32x2*)(xb1 + off);
                        const f32x4 o = (f32x4){bf2f(xq.x & 0xFFFFu), bf2f(xq.x >> 16), bf2f(xq.y & 0xFFFFu), bf2f(xq.y >> 16)} + acc[ai][bj][m][n];
                        s += (o[0] * o[0] + o[1] * o[1]) + (o[2] * o[2] + o[3] * o[3]);
                        u32x2 w; w.x = cvt_pk_bf16(o[0], o[1]); w.y = cvt_pk_bf16(o[2], o[3]); *(u32x2*)(xb1 + off) = w; }
                s += __shfl_xor(s, 16); s += __shfl_xor(s, 32);
                if (fq == 0) ssq[(size_t)row * 16 + u.pn * 4 + wc] = s; }
    }
};

struct EpiWqk {
    static constexpr bool PERM = false, AFTER_DRAIN = false;
    bf16_t* wqk;
    __device__ __forceinline__ void operator()(const f32x4 (&acc)[2][2][4][2], const pg8::Unit& u, int wr, int wc, int fr, int fq) const {
        asm volatile("" : "+v"(fr), "+v"(fq));
#pragma unroll
        for (int ai = 0; ai < 2; ++ai)
#pragma unroll
            for (int m = 0; m < 4; ++m) { const int row = u.pm * 256 + ai * 128 + wr * 64 + m * 16 + fr;
#pragma unroll
                for (int bj = 0; bj < 2; ++bj)
#pragma unroll
                    for (int n = 0; n < 2; ++n) { const f32x4 v = acc[ai][bj][m][n]; u32x2 w; w.x = cvt_pk_bf16(v[0], v[1]); w.y = cvt_pk_bf16(v[2], v[3]);
                        *(u32x2*)(wqk + (size_t)row * DM + u.pn * 256 + bj * 128 + wc * 32 + n * 16 + 4 * fq) = w; } }
    }
};
__device__ __forceinline__ unsigned mono_key(float x) { const unsigned u = __builtin_bit_cast(unsigned, x); return u ^ ((unsigned)((int)u >> 31) | 0x80000000u); }
#define CE_DESC(a, b) do { const unsigned _cmx = (a) > (b) ? (a) : (b); (b) = (a) > (b) ? (b) : (a); (a) = _cmx; } while (0)
#define CE_ASC(a, b) do { const unsigned _cmn = (a) > (b) ? (b) : (a); (b) = (a) > (b) ? (a) : (b); (a) = _cmn; } while (0)
#define SORT16_DESC(X) do { CE_DESC(X[0], X[1]); CE_DESC(X[2], X[3]); CE_DESC(X[0], X[2]); CE_DESC(X[1], X[3]); CE_DESC(X[1], X[2]); CE_DESC(X[4], X[5]); CE_DESC(X[6], X[7]); CE_DESC(X[4], X[6]); CE_DESC(X[5], X[7]); CE_DESC(X[5], X[6]); CE_DESC(X[0], X[4]); CE_DESC(X[2], X[6]); CE_DESC(X[2], X[4]); CE_DESC(X[1], X[5]); CE_DESC(X[3], X[7]); CE_DESC(X[3], X[5]); CE_DESC(X[1], X[2]); CE_DESC(X[3], X[4]); CE_DESC(X[5], X[6]); CE_DESC(X[8], X[9]); CE_DESC(X[10], X[11]); CE_DESC(X[8], X[10]); CE_DESC(X[9], X[11]); CE_DESC(X[9], X[10]); CE_DESC(X[12], X[13]); CE_DESC(X[14], X[15]); CE_DESC(X[12], X[14]); CE_DESC(X[13], X[15]); CE_DESC(X[13], X[14]); CE_DESC(X[8], X[12]); CE_DESC(X[10], X[14]); CE_DESC(X[10], X[12]); CE_DESC(X[9], X[13]); CE_DESC(X[11], X[15]); CE_DESC(X[11], X[13]); CE_DESC(X[9], X[10]); CE_DESC(X[11], X[12]); CE_DESC(X[13], X[14]); CE_DESC(X[0], X[8]); CE_DESC(X[4], X[12]); CE_DESC(X[4], X[8]); CE_DESC(X[2], X[10]); CE_DESC(X[6], X[14]); CE_DESC(X[6], X[10]); CE_DESC(X[2], X[4]); CE_DESC(X[6], X[8]); CE_DESC(X[10], X[12]); CE_DESC(X[1], X[9]); CE_DESC(X[5], X[13]); CE_DESC(X[5], X[9]); CE_DESC(X[3], X[11]); CE_DESC(X[7], X[15]); CE_DESC(X[7], X[11]); CE_DESC(X[3], X[5]); CE_DESC(X[7], X[9]); CE_DESC(X[11], X[13]); CE_DESC(X[1], X[2]); CE_DESC(X[3], X[4]); CE_DESC(X[5], X[6]); CE_DESC(X[7], X[8]); CE_DESC(X[9], X[10]); CE_DESC(X[11], X[12]); CE_DESC(X[13], X[14]); } while (0)
#define TOP16_MERGE(L, P) do { _Pragma("unroll") for (int _i = 0; _i < 16; ++_i) L[_i] = L[_i] > P[15 - _i] ? L[_i] : P[15 - _i]; \
    _Pragma("unroll") for (int _j = 8; _j > 0; _j >>= 1) _Pragma("unroll") for (int _i = 0; _i < 16; ++_i) { const int _l = _i ^ _j; if (_l > _i) CE_DESC(L[_i], L[_l]); } } while (0)
struct EpiTopk {
    static constexpr bool PERM = false, AFTER_DRAIN = true;
    const float* ssq; int* sele; float* selg;
    __device__ __forceinline__ void fused(const f32x4 (&acc)[2][2][4][2], const pg8::Unit& u, int wr, int wc, int fr, int fq, LAS unsigned char* lds, int wid, int lane) const {
        asm volatile("" : "+v"(fr), "+v"(fq), "+v"(lane));
        constexpr int SCP = 260;
        LAS float* SC = (LAS float*)lds;
        LAS unsigned* XL = (LAS unsigned*)(lds + 128 * SCP * 4);
        LAS float* LST = (LAS float*)lds;
        const int tid = wid * 64 + lane;
#pragma unroll
        for (int ai = 0; ai < 2; ++ai) {
#pragma unroll
            for (int m = 0; m < 4; ++m) {
                const int rr = 64 * wr + 16 * m + fr, row = u.pm * 256 + ai * 128 + rr;
                const f32x4* sp = (const f32x4*)(ssq + (size_t)row * 16); const f32x4 s0 = sp[0], s1 = sp[1], s2 = sp[2], s3 = sp[3];
                const float ssum = ((s0[0] + s0[1]) + (s0[2] + s0[3])) + ((s1[0] + s1[1]) + (s1[2] + s1[3])) + ((s2[0] + s2[1]) + (s2[2] + s2[3])) + ((s3[0] + s3[1]) + (s3[2] + s3[3]));
                const float rs = rsqrtf(ssum * (1.0f / DM) + EPS);
#pragma unroll
                for (int bj = 0; bj < 2; ++bj)
#pragma unroll
                    for (int n = 0; n < 2; ++n) { const int c = 128 * bj + 32 * wc + 16 * n + 4 * fq; *(LAS f32x4*)(SC + rr * SCP + c) = acc[ai][bj][m][n] * rs; }
            }
            LDS_WAIT(); __builtin_amdgcn_s_barrier(); asm volatile("" ::: "memory");
            const int rr = tid & 127, part = tid >> 7, half = part >> 1, sub = part & 1;
            unsigned L[16];
            { const LAS f32x4* src = (const LAS f32x4*)(SC + rr * SCP + 128 * half + 64 * sub);
#define LOADKEYS(X, g) do { _Pragma("unroll") for (int i4 = 0; i4 < 4; ++i4) { const f32x4 sv = src[4 * (g) + i4]; _Pragma("unroll") for (int i1 = 0; i1 < 4; ++i1) \
                  X[4 * i4 + i1] = (mono_key(sv[i1]) & 0xFFFFFF80u) | (unsigned)(127 - (64 * sub + 16 * (g) + 4 * i4 + i1)); } } while (0)
              LOADKEYS(L, 0); SORT16_DESC(L);
#pragma unroll 1
              for (int g = 1; g < 4; ++g) {
                  unsigned Gp[16];
                  LOADKEYS(Gp, g);
                  SORT16_DESC(Gp); TOP16_MERGE(L, Gp);
              }
#undef LOADKEYS
            }
            if (sub == 1) {
#pragma unroll
                for (int i = 0; i < 16; ++i) XL[(rr * 2 + half) * 16 + i] = L[i]; }
            LDS_WAIT(); __builtin_amdgcn_s_barrier(); asm volatile("" ::: "memory");
            float v[16]; int id[16];
            if (sub == 0) {
                unsigned Pp[16];
#pragma unroll
                for (int i = 0; i < 16; ++i) Pp[i] = XL[(rr * 2 + half) * 16 + i];
                TOP16_MERGE(L, Pp);
#pragma unroll
                for (int i = 0; i < 16; ++i) { id[i] = 127 - (int)(L[i] & 127u); v[i] = SC[rr * SCP + 128 * half + id[i]]; }
            }
            LDS_WAIT(); __builtin_amdgcn_s_barrier(); asm volatile("" ::: "memory");
            if (sub == 0) {
#pragma unroll
                for (int i = 0; i < 16; ++i) { LST[(rr * 2 + half) * 32 + i] = v[i]; LST[(rr * 2 + half) * 32 + 16 + i] = __builtin_bit_cast(float, id[i]); } }
            LDS_WAIT(); __builtin_amdgcn_s_barrier(); asm volatile("" ::: "memory");
            if (tid < 128) {
                const int r2 = tid;
                float v1[16], v2[16];
#pragma unroll
                for (int i = 0; i < 16; ++i) { v1[i] = LST[(r2 * 2 + 0) * 32 + i]; v2[i] = LST[(r2 * 2 + 1) * 32 + i]; }
#define CKEY(i, j) ((mono_key(v1[i] + v2[j]) & 0xFFFFFF00u) | (unsigned)(255 - ((i) * 16 + (j))))
                unsigned C[16], P[16];
#pragma unroll
                for (int j = 0; j < 16; ++j) C[j] = CKEY(0, j);
#pragma unroll
                for (int j = 0; j < 16; ++j) P[j] = j < 8 ? CKEY(1, j) : 0u;
                TOP16_MERGE(C, P);
                P[0] = CKEY(2, 0); P[1] = CKEY(2, 1); P[2] = CKEY(2, 2); P[3] = CKEY(2, 3); P[4] = CKEY(2, 4); P[5] = CKEY(3, 0); P[6] = CKEY(3, 1); P[7] = CKEY(3, 2); P[8] = CKEY(3, 3);
                P[9] = CKEY(4, 0); P[10] = CKEY(4, 1); P[11] = CKEY(4, 2); P[12] = CKEY(5, 0); P[13] = CKEY(5, 1); P[14] = CKEY(6, 0); P[15] = CKEY(6, 1);
                SORT16_DESC(P); TOP16_MERGE(C, P);
                P[0] = CKEY(7, 0); P[1] = CKEY(7, 1);
#pragma unroll
                for (int i = 8; i < 16; ++i) P[i - 6] = CKEY(i, 0);
#pragma unroll
                for (int i = 10; i < 16; ++i) P[i] = 0u;
                SORT16_DESC(P); TOP16_MERGE(C, P);
#undef CKEY
                float sc[16]; int eid[16]; float mx = -3.0e38f;
#pragma unroll
                for (int k = 0; k < 16; ++k) { const int ci = 255 - (int)(C[k] & 255u), i = ci >> 4, j = ci & 15;
                    sc[k] = LST[(r2 * 2 + 0) * 32 + i] + LST[(r2 * 2 + 1) * 32 + j];
                    const int e1 = __builtin_bit_cast(int, LST[(r2 * 2 + 0) * 32 + 16 + i]), e2 = __builtin_bit_cast(int, LST[(r2 * 2 + 1) * 32 + 16 + j]);
                    eid[k] = e1 * 128 + e2; mx = fmaxf(mx, sc[k]); }
                float sum = 0.f;
#pragma unroll
                for (int k = 0; k < 16; ++k) { sc[k] = __expf(sc[k] - mx); sum += sc[k]; }
                const float inv = 1.0f / sum;
                LAS int* pe = (LAS int*)XL + r2 * 16; LAS float* pg = (LAS float*)XL + 2048 + r2 * 16;
#pragma unroll
                for (int k = 0; k < 16; ++k) { pe[k] = eid[k]; pg[k] = sc[k] * inv; }
            }
            LDS_WAIT(); __builtin_amdgcn_s_barrier(); asm volatile("" ::: "memory");
#pragma unroll
            for (int j = 0; j < 4; ++j) {
                const int idx = tid + 512 * j, t = u.pm * 256 + ai * 128 + (idx >> 4);
                sele[(size_t)t * 128 + u.pn * 16 + (idx & 15)] = ((const LAS int*)XL)[idx];
                selg[(size_t)t * 128 + u.pn * 16 + (idx & 15)] = ((const LAS float*)XL)[2048 + idx];
            }
            LDS_WAIT(); __builtin_amdgcn_s_barrier(); asm volatile("" ::: "memory");
        }
    }
};

template <int TT>
__device__ __forceinline__ void conv_tiles(LAS unsigned char* lds, const float* PAR, const bf16_t* HCONV, bf16_t* YCAT, int first, int last, int stride, const int wave0) {
    int tid = (wave0 << 6) | lane_id_(); asm volatile("" : "+v"(tid));
    const int lane = tid & 63, wave = __builtin_amdgcn_readfirstlane(tid >> 6);
    LAS unsigned char* HC = lds;
    LAS f32x2* RED = (LAS f32x2*)(lds + 98304);
    const int c = tid;
    float w[31];
#pragma unroll
    for (int k = 0; k < 31; ++k) w[k] = PAR[PO_CW + k * 512 + c];
    const float cb = PAR[PO_CB + c], lng = PAR[PO_LNG + c], lnb = PAR[PO_LNB + c];
    const bool b0 = (lane & 1) != 0, b1 = (lane & 2) != 0, b2 = (lane & 4) != 0, b3 = (lane & 8) != 0;
    for (int tt = first; tt < last; tt += stride) {
        const int t0 = tt * TT, pos0 = t0 & (SEQ - 1);
        {
            constexpr int NST = ((TT + 30) * 64 + NTHR - 1) / NTHR;
            u32x4 val[NST];
#pragma unroll
            for (int q = 0; q < NST; ++q) { const int idx = tid + q * NTHR, r = idx >> 6, cc = idx & 63; val[q] = (u32x4){0u, 0u, 0u, 0u};
                if (idx < (TT + 30) * 64 && pos0 - 30 + r >= 0) val[q] = *(const u32x4*)(HCONV + (size_t)(t0 - 30 + r) * 512 + cc * 8); }
#pragma unroll
            for (int q = 0; q < NST; ++q) { const int idx = tid + q * NTHR, r = idx >> 6, cc = idx & 63; if (idx < (TT + 30) * 64) *(LAS u32x4*)(HC + r * 1024 + cc * 16) = val[q]; }
        }
        LDS_WAIT(); __syncthreads();
        for (int tb = 0; tb < TT / 16; ++tb) {
            float in[46];
#pragma unroll
            for (int i = 0; i < 46; ++i) in[i] = bf2f(*(const LAS unsigned short*)(HC + (16 * tb + i) * 1024 + c * 2));
            float o[16];
#pragma unroll
            for (int t = 0; t < 16; ++t) { float a = cb;
#pragma unroll
                for (int k = 0; k < 31; ++k) a += w[k] * in[t + k];
                o[t] = a; }
            {
                float a1[8], a2[8];
#define XCH1(v) dpp_f<0xB1>(v)
#define XCH2(v) dpp_f<0x4E>(v)
#define XCH4(v) dpp_f<0x141>(dpp_f<0x1B>(v))
#define XCH8(v) dpp_f<0x128>(v)
#pragma unroll
                for (int j = 0; j < 8; ++j) { const float e = o[2 * j], d = o[2 * j + 1], e2 = e * e, d2 = d * d;
                    const float k1 = b0 ? d : e, s1 = b0 ? e : d, k2 = b0 ? d2 : e2, s2 = b0 ? e2 : d2; a1[j] = k1 + XCH1(s1); a2[j] = k2 + XCH1(s2); }
#pragma unroll
                for (int j = 0; j < 4; ++j) { const float k1 = b1 ? a1[2 * j + 1] : a1[2 * j], s1 = b1 ? a1[2 * j] : a1[2 * j + 1], k2 = b1 ? a2[2 * j + 1] : a2[2 * j], s2 = b1 ? a2[2 * j] : a2[2 * j + 1];
                    a1[j] = k1 + XCH2(s1); a2[j] = k2 + XCH2(s2); }
#pragma unroll
                for (int j = 0; j < 2; ++j) { const float k1 = b2 ? a1[2 * j + 1] : a1[2 * j], s1 = b2 ? a1[2 * j] : a1[2 * j + 1], k2 = b2 ? a2[2 * j + 1] : a2[2 * j], s2 = b2 ? a2[2 * j] : a2[2 * j + 1];
                    a1[j] = k1 + XCH4(s1); a2[j] = k2 + XCH4(s2); }
                { const float k1 = b3 ? a1[1] : a1[0], s1 = b3 ? a1[0] : a1[1], k2 = b3 ? a2[1] : a2[0], s2 = b3 ? a2[0] : a2[1]; a1[0] = k1 + XCH8(s1); a2[0] = k2 + XCH8(s2); }
                float r1 = a1[0], r2 = a2[0];
                r1 += __builtin_bit_cast(float, __builtin_amdgcn_ds_swizzle(__builtin_bit_cast(int, r1), 0x401F)); r2 += __builtin_bit_cast(float, __builtin_amdgcn_ds_swizzle(__builtin_bit_cast(int, r2), 0x401F));
                { const u32x2 p1 = __builtin_amdgcn_permlane32_swap(__builtin_bit_cast(unsigned, r1), __builtin_bit_cast(unsigned, r1), false, false), p2 = __builtin_amdgcn_permlane32_swap(__builtin_bit_cast(unsigned, r2), __builtin_bit_cast(unsigned, r2), false, false);
                  r1 += __builtin_bit_cast(float, lane < 32 ? p1.y : p1.x); r2 += __builtin_bit_cast(float, lane < 32 ? p2.y : p2.x); }
                if (lane < 16) RED[(tb * 16 + lane) * 8 + wave] = (f32x2){r1, r2};
#undef XCH1
#undef XCH2
#undef XCH4
#undef XCH8
            }
            LDS_WAIT(); __syncthreads();
            float mu_l, rs_l;
            { const LAS f32x4* rp = (const LAS f32x4*)(RED + (tb * 16 + (lane & 15)) * 8); const f32x4 q0 = rp[0], q1 = rp[1], q2 = rp[2], q3 = rp[3];
              const float s1 = ((q0[0] + q0[2]) + (q1[0] + q1[2])) + ((q2[0] + q2[2]) + (q3[0] + q3[2])), s2 = ((q0[1] + q0[3]) + (q1[1] + q1[3])) + ((q2[1] + q2[3]) + (q3[1] + q3[3]));
              mu_l = s1 * (1.0f / 512.0f); const float var = fmaxf(s2 * (1.0f / 512.0f) - mu_l * mu_l, 0.f); rs_l = rsqrtf(var + EPS); }
#pragma unroll
            for (int t = 0; t < 16; ++t) {
                const float mu = __builtin_bit_cast(float, __builtin_amdgcn_readlane(__builtin_bit_cast(int, mu_l), t)), rs = __builtin_bit_cast(float, __builtin_amdgcn_readlane(__builtin_bit_cast(int, rs_l), t));
                const float y = (o[t] - mu) * rs * lng + lnb, z = y * sigmoidf_(y);
                *(LAS unsigned short*)(HC + (16 * tb + t) * 1024 + c * 2) = (unsigned short)f2bf(z); }
        }
        LDS_WAIT(); __syncthreads();
        for (int idx = tid; idx < TT * 64; idx += NTHR) { const int r = idx >> 6, cc = idx & 63;
            *(u32x4*)(YCAT + (size_t)(t0 + r) * DM + 512 + cc * 8) = *(const LAS u32x4*)(HC + r * 1024 + cc * 16); }
        LDS_WAIT(); __syncthreads();
    }
}

#define XB_TMO      128
#define XB_XCNT(j)  (256  + 64 * (j))
#define XB_XSUB(j)  (1280 + 64 * (j))
#define XB_XGEN(j)  (2304 + 64 * (j))
#define XB_TOP      3328
#define XB_TOPGEN   3392
#define XCD_BAR_WORDS 3456
#define XB_SPIN_CAP (1u << 22)
__device__ __forceinline__ unsigned xb_ld(unsigned* p)              { return __hip_atomic_load(p, __ATOMIC_RELAXED, __HIP_MEMORY_SCOPE_AGENT); }
__device__ __forceinline__ unsigned xb_add(unsigned* p, unsigned v) { return __hip_atomic_fetch_add(p, v, __ATOMIC_RELAXED, __HIP_MEMORY_SCOPE_AGENT); }
__device__ __forceinline__ unsigned xb_xcc_id() { return (unsigned)__builtin_amdgcn_s_getreg((3 << 11) | 20) & 0xFu; }
#define XB_SPIN(cond, bar) do { unsigned _sp = 0; while (cond) { __builtin_amdgcn_s_sleep(1); \
    if ((++_sp & 255u) == 0u) { if (xb_ld(&(bar)[XB_TMO])) break; if (_sp > XB_SPIN_CAP) { atomicAdd(&(bar)[XB_TMO], 1u); break; } } } } while (0)
struct XcdBarrier { unsigned* bar; unsigned x; volatile LAS unsigned* st; };
__device__ __forceinline__ XcdBarrier xcd_barrier_post(unsigned* bar, volatile LAS unsigned* st, const bool t0) {
    XcdBarrier b; b.bar = bar; b.x = xb_xcc_id(); b.st = st;
    if (t0) (void)xb_add(&bar[XB_XCNT(b.x)], 1u);
    return b;
}
__device__ __forceinline__ void xcd_barrier_complete(unsigned* bar, unsigned x, unsigned& nloc, unsigned& nx) {
    const unsigned G = gridDim.x * gridDim.y * gridDim.z;
    unsigned sum, cnt, mine, sp = 0u;
    for (;;) {
        sum = 0u; cnt = 0u; mine = 0u;
#pragma unroll
        for (unsigned j = 0; j < 16; ++j) { const unsigned c = xb_ld(&bar[XB_XCNT(j)]); sum += c; cnt += (c > 0u) ? 1u : 0u; mine = (j == x) ? c : mine; }
        if (sum == G) break;
        __builtin_amdgcn_s_sleep(1);
        if ((++sp & 255u) == 0u) { if (xb_ld(&bar[XB_TMO])) break; if (sp > XB_SPIN_CAP) { atomicAdd(&bar[XB_TMO], 1u); break; } }
    }
    nloc = mine > 0u ? mine : 1u; nx = cnt > 0u ? cnt : 1u;
}
__device__ __forceinline__ void xcd_barrier(const XcdBarrier& b, const bool t0) {
    asm volatile("s_waitcnt vmcnt(0)" ::: "memory");
    __syncthreads();
    if (t0) {
        unsigned* bar = b.bar;
        __builtin_amdgcn_s_waitcnt(0);
        unsigned nloc = b.st[0], nx = b.st[1];
        if (nloc == 0u) { xcd_barrier_complete(bar, b.x, nloc, nx); b.st[0] = nloc; b.st[1] = nx; }
        const unsigned old = xb_add(&bar[XB_XSUB(b.x)], 1u);
        const unsigned gen = old / nloc;
        if (old + 1u == (gen + 1u) * nloc) {
            __builtin_amdgcn_fence(__ATOMIC_RELEASE, "agent");
            asm volatile("s_waitcnt vmcnt(0)" ::: "memory");
            const unsigned og = xb_add(&bar[XB_TOP], 1u);
            const unsigned tg = og / nx;
            if (og + 1u == (tg + 1u) * nx) xb_add(&bar[XB_TOPGEN], 1u);
            else XB_SPIN(xb_ld(&bar[XB_TOPGEN]) == tg, bar);
            __builtin_amdgcn_fence(__ATOMIC_ACQUIRE, "agent");
            xb_add(&bar[XB_XGEN(b.x)], 1u);
            asm volatile("s_waitcnt vmcnt(0)" ::: "memory");
        } else {
            XB_SPIN(xb_ld(&bar[XB_XGEN(b.x)]) == gen, bar);
            __builtin_amdgcn_fence(__ATOMIC_ACQUIRE, "agent");
            asm volatile("s_waitcnt vmcnt(0)" ::: "memory");
        }
    }
    __syncthreads();
}

struct Args { const float* in[25]; float* out; unsigned char* ws; int ph_lo, ph_hi; };
enum { I_X = 0, I_G1, I_WIN, I_LRE, I_LIM, I_LDT, I_BRE, I_BIM, I_CRE, I_CIM, I_D, I_GLUW, I_GLUB, I_CW, I_CB, I_LNG, I_LNB, I_WOUT, I_G2, I_WQ, I_K1, I_K2, I_U, I_V, I_FG };
constexpr int NPHASE = 9;

__device__ __forceinline__ void p0_transpose_item(const float* W, int ldw, int src0, const float* gk, bf16_t* WT, int KT, int dst0, int k0, LAS float* scr, int lane) {
    float wv_[32];
#pragma unroll
    for (int i = 0; i < 32; ++i) { const int kk = 2 * i + (lane >> 5); wv_[i] = W[(size_t)(k0 + kk) * ldw + src0 + (lane & 31)]; }
    const float gkv = gk ? gk[k0 + (lane & 63)] : 1.0f;
#pragma unroll
    for (int i = 0; i < 32; ++i) { const int kk = 2 * i + (lane >> 5); scr[kk * 33 + (lane & 31)] = wv_[i] * __shfl(gkv, kk); }
    LDS_WAIT(); asm volatile("" ::: "memory");
    const int c = lane & 7;
#pragma unroll
    for (int j = 0; j < 4; ++j) { const int n = (lane >> 3) + 8 * j; const LAS float* s = scr + (8 * c) * 33 + n;
        u32x4 o; o.x = cvt_pk_bf16(s[0 * 33], s[1 * 33]); o.y = cvt_pk_bf16(s[2 * 33], s[3 * 33]); o.z = cvt_pk_bf16(s[4 * 33], s[5 * 33]); o.w = cvt_pk_bf16(s[6 * 33], s[7 * 33]);
        *(u32x4*)(WT + (size_t)(dst0 + n) * KT + k0 + 8 * c) = o; }
    LDS_WAIT(); asm volatile("" ::: "memory");
}

typedef __attribute__((address_space(4))) const Args CArgs;
__global__ void __launch_bounds__(NTHR, 2) fwd_kernel(Args args_unused) {
    extern __shared__ __attribute__((aligned(16))) unsigned char lds_raw[];
    LAS unsigned char* lds = (LAS unsigned char*)lds_raw;
    CArgs* ap = (CArgs*)__builtin_amdgcn_kernarg_segment_ptr();
    struct { float* out; unsigned char* ws; int ph_lo, ph_hi; } args = {ap->out, ap->ws, ap->ph_lo, ap->ph_hi};
    const int wave0 = __builtin_amdgcn_readfirstlane((int)threadIdx.x >> 6);
#define T0_() (wave0 == 0 && lane_id_() == 0)
    const int G = gridDim.x, bx = blockIdx.x;
    const int vcu = (G % 8 == 0) ? (bx % 8) * (G / 8) + bx / 8 : bx;
    const int NGW = G * NWAVES;
#define PH_IDS() int tid = (wave0 << 6) | lane_id_(); asm volatile("" : "+v"(tid)); const int lane = tid & 63, wave = __builtin_amdgcn_readfirstlane(tid >> 6), gw = vcu * NWAVES + wave; (void)lane; (void)gw;
    unsigned char* ws = args.ws;
    bf16_t* WIN = (bf16_t*)(ws + WS_WIN); bf16_t* WOUT = (bf16_t*)(ws + WS_WOUT); bf16_t* WQB = (bf16_t*)(ws + WS_WQ); bf16_t* WQK = (bf16_t*)(ws + WS_WQK);
    bf16_t* KEXT = (bf16_t*)(ws + WS_KEXT); bf16_t* W1EXT = (bf16_t*)(ws + WS_W1EXT); bf16_t* KBLK = (bf16_t*)(ws + WS_KBLK);
    float* LPOW = (float*)(ws + WS_LPOW); float* RSTD1 = (float*)(ws + WS_RSTD1); float* SSQ2 = (float*)(ws + WS_SSQ2);
    int* SELE = (int*)(ws + WS_SELE); float* SELG = (float*)(ws + WS_SELG);
    unsigned char* UTAB = ws + WS_UTAB; unsigned char* VTAB = ws + WS_VTAB; int* EXPU = (int*)(ws + WS_EXPU); int* EXPV = (int*)(ws + WS_EXPV); bf16_t* XB = (bf16_t*)(ws + WS_XB);
    bf16_t* UEXT = (bf16_t*)(ws + WS_UEXT); bf16_t* HCONV = (bf16_t*)(ws + WS_HCONV); bf16_t* YCAT = (bf16_t*)(ws + WS_YCAT);
    float* X1 = args.out;
    float* PAR = (float*)(ws + WS_PAR);
    const int lo = args.ph_lo, hi = args.ph_hi;
    cooperative_groups::grid_group grid_ = cooperative_groups::this_grid();
    volatile LAS unsigned* MISC = (volatile LAS unsigned*)(lds + LDS_BYTES - 64);
    if (wave0 == 0 && lane_id_() < 16) MISC[lane_id_()] = 0u;
    __syncthreads();
    const XcdBarrier xbar = xcd_barrier_post((unsigned*)(ws + WS_CTL), MISC, T0_());
#define SEAM(k) do { if (lo <= (k) && (k) + 1 < hi) { if (lo < 0) grid_.sync(); else xcd_barrier(xbar, T0_()); } } while (0)
#ifndef PH_MASK
#define PH_MASK 0xFFFF
#endif
#define REP_U 1
#define REP_V 1
#define REP_MASK 0
#define IN(k) ((((PH_MASK) >> (k)) & 1) && lo <= (k) && (k) < hi)

    if (IN(0)) { for (int rep_ = 0; rep_ < (((REP_MASK) >> 0) & 1) + 1; ++rep_) { if (rep_) grid_.sync();
        PH_IDS();
        CArgs* pa = ap; asm volatile("" : "+s"(pa));
#define AIN(i) (pa->in[i])
        if (bx < NG) {
            const int g = bx;
            LAS f32x2* LP = (LAS f32x2*)(lds + 70000);
            LAS f32x2* BB = (LAS f32x2*)(lds + 70000 + 8704);
            LAS f32x2* CC = (LAS f32x2*)(lds + 70000 + 16896);
            LAS float* TT = (LAS float*)(lds + 70000 + 25088);
            if (tid < 64) {
                const int p = tid;
                const double lr = (double)AIN(I_LRE)[g * 64 + p], li = (double)AIN(I_LIM)[g * 64 + p], dt = exp((double)AIN(I_LDT)[g]);
                const double m1 = exp(lr * dt), a1 = li * dt, lbr = m1 * cos(a1), lbi = m1 * sin(a1);
                const double nr = lbr - 1.0, ni = lbi, den = lr * lr + li * li, fr_ = (nr * lr + ni * li) / den, fi_ = (ni * lr - nr * li) / den;
                { double cr_ = 1.0, ci_ = 0.0;
                  for (int n = 0; n < 17; ++n) { LP[n * 64 + p] = (f32x2){(float)cr_, (float)ci_}; const double t_ = cr_ * lbr - ci_ * lbi; ci_ = cr_ * lbi + ci_ * lbr; cr_ = t_; } }
                for (int h = 0; h < 16; ++h) { const double br = (double)AIN(I_BRE)[(g * 64 + p) * 16 + h], bi = (double)AIN(I_BIM)[(g * 64 + p) * 16 + h];
                    BB[p * 16 + h] = (f32x2){(float)(fr_ * br - fi_ * bi), (float)(fr_ * bi + fi_ * br)}; }
                for (int h = 0; h < 16; ++h) CC[h * 64 + p] = (f32x2){AIN(I_CRE)[(g * 16 + h) * 64 + p], AIN(I_CIM)[(g * 16 + h) * 64 + p]};
            } else if (tid < 128) {
                const int p = tid - 64;
                const double lr = (double)AIN(I_LRE)[g * 64 + p], li = (double)AIN(I_LIM)[g * 64 + p], dt = exp((double)AIN(I_LDT)[g]);
                const double m16 = exp(lr * dt * 16.0), a16 = li * dt * 16.0, m512 = exp(lr * dt * 512.0), a512 = li * dt * 512.0;
                *(f32x4*)(LPOW + (size_t)(g * 64 + p) * 4) = (f32x4){(float)(m16 * cos(a16)), (float)(m16 * sin(a16)), (float)(m512 * cos(a512)), (float)(m512 * sin(a512))};
            }
            __syncthreads();
            {
                const int lag = tid >> 5, ho = (tid >> 1) & 15, h8 = (tid & 1) * 8; float s8[8];
#pragma unroll
                for (int e = 0; e < 8; ++e) s8[e] = 0.f;
#pragma unroll 2
                for (int p = 0; p < 64; ++p) { const f32x2 c = CC[ho * 64 + p], l = LP[lag * 64 + p];
                    const float cr = c.x * l.x - c.y * l.y, ci = c.x * l.y + c.y * l.x;
                    const LAS f32x4* bp = (const LAS f32x4*)(BB + p * 16 + h8);
#pragma unroll
                    for (int e2 = 0; e2 < 4; ++e2) { const f32x4 b2 = bp[e2]; s8[2 * e2] += cr * b2[0] - ci * b2[1]; s8[2 * e2 + 1] += cr * b2[2] - ci * b2[3]; } }
#pragma unroll
                for (int e = 0; e < 8; ++e) TT[(lag * 16 + ho) * 16 + h8 + e] = s8[e];
            }
            __syncthreads();
            for (int o = tid; o < 256 * 48; o += NTHR) { const int r = o / 48, k8 = (o % 48) * 8, j = r >> 4, ho = r & 15; float v[8];
#pragma unroll
                for (int e = 0; e < 8; ++e) { const int kk = k8 + e; float x;
                    if (kk < 256) { const int ji = kk >> 4, hi_ = kk & 15; x = (ji <= j) ? TT[((j - ji) * 16 + ho) * 16 + hi_] : 0.f; if (ji == j && hi_ == ho) x += AIN(I_D)[g * 16 + ho]; }
                    else { const int p = (kk - 256) & 63; const f32x2 c = CC[ho * 64 + p], l = LP[(j + 1) * 64 + p]; x = (kk < 320) ? (c.x * l.x - c.y * l.y) : -(c.x * l.y + c.y * l.x); }
                    v[e] = x; }
                u32x4 w; w.x = cvt_pk_bf16(v[0], v[1]); w.y = cvt_pk_bf16(v[2], v[3]); w.z = cvt_pk_bf16(v[4], v[5]); w.w = cvt_pk_bf16(v[6], v[7]);
                *(u32x4*)(KEXT + ((size_t)g * 256 + r) * KX + k8) = w; }
            for (int o = tid; o < 256 * 32; o += NTHR) { const int r = o >> 5, k8 = (o & 31) * 8; float v[8];
#pragma unroll
                for (int e = 0; e < 8; ++e) { const int kk = k8 + e, j = kk >> 4, h = kk & 15; float x = 0.f;
                    if (r < 128) { const int p = r & 63; const f32x2 l = LP[(15 - j) * 64 + p], b = BB[p * 16 + h]; x = (r < 64) ? (l.x * b.x - l.y * b.y) : (l.x * b.y + l.y * b.x); }
                    v[e] = x; }
                u32x4 w; w.x = cvt_pk_bf16(v[0], v[1]); w.y = cvt_pk_bf16(v[2], v[3]); w.z = cvt_pk_bf16(v[4], v[5]); w.w = cvt_pk_bf16(v[6], v[7]);
                *(u32x4*)(W1EXT + ((size_t)g * 256 + r) * 256 + k8) = w; }
            __syncthreads();
        }
        const int nwk_self = (bx < NG) ? 1 : 2, NWK = (G - NG) * NWAVES * 2 + NG * NWAVES;
        for (int wv = 0; wv < nwk_self; ++wv) {
            const int wk = (bx < NG) ? (G - NG) * NWAVES * 2 + bx * NWAVES + wave : ((bx - NG) * NWAVES + wave) * 2 + wv;
            {
                LAS float* scr = (LAS float*)(lds + wave * 8448);
                constexpr int I_IN = 16 * 48, I_OUT = 16 * 32;
                for (int it = wk; it < I_IN + I_OUT; it += NWK) {
                    int r = it;
                    if (r < I_IN) { const int kb = r / 48, nb = r % 48, n0 = 32 * nb; int src0 = n0;
                        if (n0 >= 512) { const int q = (n0 - 512) >> 8, bj = ((n0 - 512) >> 7) & 1, rr = n0 & 127; src0 = 512 + 512 * bj + 128 * q + rr; }
                        p0_transpose_item(AIN(I_WIN), 1536, src0, AIN(I_G1), WIN, DM, n0, 64 * kb, scr, lane); continue; }
                    r -= I_IN;
                    { const int kb = r / 32, nb = r % 32; p0_transpose_item(AIN(I_WOUT), 1024, 32 * nb, nullptr, WOUT, DM, 32 * nb, 64 * kb, scr, lane); }
                }
            }
            for (int row = wk; row < DM; row += NWK) {
                const float gk = AIN(I_G2)[row];
                const f32x4* wr_ = (const f32x4*)(AIN(I_WQ) + (size_t)row * NQ) + lane; u32x2* o8 = (u32x2*)(WQB + (size_t)row * NQ) + lane;
                f32x4 v[8];
#pragma unroll
                for (int j = 0; j < 8; ++j) v[j] = wr_[64 * j];
#pragma unroll
                for (int j = 0; j < 8; ++j) { u32x2 w; w.x = cvt_pk_bf16(v[j][0] * gk, v[j][1] * gk); w.y = cvt_pk_bf16(v[j][2] * gk, v[j][3] * gk); o8[64 * j] = w; }
            }
            for (int row0 = wk; row0 < NTOK; row0 += 4 * NWK) {
                f32x4 v[4][4];
#pragma unroll
                for (int q = 0; q < 4; ++q) { const int row = row0 + q * NWK; if (row < NTOK) { const f32x4* xr = (const f32x4*)(AIN(I_X) + (size_t)row * DM) + lane;
#pragma unroll
                    for (int j = 0; j < 4; ++j) v[q][j] = xr[64 * j]; } }
#pragma unroll
                for (int q = 0; q < 4; ++q) { const int row = row0 + q * NWK; if (row < NTOK) { float sq = 0.f;
#pragma unroll
                    for (int j = 0; j < 4; ++j) sq += (v[q][j][0] * v[q][j][0] + v[q][j][1] * v[q][j][1]) + (v[q][j][2] * v[q][j][2] + v[q][j][3] * v[q][j][3]);
                    sq = wave_sum(sq);
                    if (lane == 0) RSTD1[row] = rsqrtf(sq * (1.0f / DM) + EPS);
                    u32x2* o8 = (u32x2*)(XB + (size_t)row * DM) + lane;
#pragma unroll
                    for (int j = 0; j < 4; ++j) { u32x2 w; w.x = cvt_pk_bf16(v[q][j][0], v[q][j][1]); w.y = cvt_pk_bf16(v[q][j][2], v[q][j][3]); o8[64 * j] = w; } } }
            }
        }
        {
            const int gt = gw * 64 + lane, NGT = NGW * 64;
            for (int i = gt; i < PO_END; i += NGT) { float v;
                if (i < PO_CB) v = AIN(I_CW)[i]; else if (i < PO_LNG) v = AIN(I_CB)[i - PO_CB]; else if (i < PO_LNB) v = AIN(I_LNG)[i - PO_LNG]; else if (i < PO_GLUW) v = AIN(I_LNB)[i - PO_LNB];
                else if (i < PO_GLUB) v = AIN(I_GLUW)[i - PO_GLUW]; else if (i < PO_G2) v = AIN(I_GLUB)[i - PO_GLUB]; else if (i < PO_FG) v = AIN(I_G2)[i - PO_G2]; else v = AIN(I_FG)[i - PO_FG];
                PAR[i] = v; }
        }
        for (int row = gw; row < 256; row += NGW) {
            const int c4 = lane * 4; float v[4];
#pragma unroll
            for (int e = 0; e < 4; ++e) { const int c = c4 + e; float x = 0.f;
                if (row < 128 && c < 128) x = AIN(I_K1)[row * 128 + c];
                if (row >= 128 && c >= 128) x = AIN(I_K2)[(row - 128) * 128 + (c - 128)];
                v[e] = x; }
            u32x2 w; w.x = cvt_pk_bf16(v[0], v[1]); w.y = cvt_pk_bf16(v[2], v[3]); *(u32x2*)(KBLK + row * 256 + c4) = w;
        }
    } }

    SEAM(0);
    if (IN(1)) { for (int rep_ = 0; rep_ < (((REP_MASK) >> 1) & 1) + 1; ++rep_) { if (rep_) grid_.sync();
        pg8::Gemm g{DM, DM, DM}; pg8::GridOrder S; S.init(XB, WIN, DM, DM, NTOK, 1536, G, bx);
        EpiP1 E{RSTD1, UEXT, HCONV};
        pg8::gemm_phase<EpiP1, pg8::GridOrder, true>(lds, g, S, E, wave0);
        if (bx + G >= 384) {
            for (int w = bx - (384 - G); w < 32; w += 2 * G - 384) {
                __syncthreads();
                const int h = w >> 2, kb4 = w & 3;
                pg8::Gemm gm{256, 256, NQ}; pg8::OneUnit S; S.valid = 1; S.u.pm = h; S.u.pn = kb4;
                S.u.A = (const char*)KBLK; S.u.B = (const char*)(WQB + (size_t)kb4 * 256 * NQ + h * 256);
                EpiWqk E{WQK};
                pg8::gemm_phase<EpiWqk, pg8::OneUnit, false>(lds, gm, S, E, wave0);
                __syncthreads();
            }
            PH_IDS();
            CArgs* pa = ap; asm volatile("" : "+s"(pa));
            const int TNW = (2 * G - 384) * NWAVES, tw = (bx - (384 - G)) * NWAVES + wave;
            for (int row0 = tw; row0 < 2 * NEXP; row0 += 4 * TNW) {
                f32x4 v[4][4];
#pragma unroll
                for (int q = 0; q < 4; ++q) { const int row = row0 + q * TNW; if (row < 2 * NEXP) { const float* src = (row < NEXP) ? pa->in[I_U] + (size_t)row * DM : pa->in[I_V] + (size_t)(row - NEXP) * DM; const f32x4* xr = (const f32x4*)src + 4 * lane;
#pragma unroll
                    for (int j = 0; j < 4; ++j) v[q][j] = xr[j]; } }
#pragma unroll
                for (int q = 0; q < 4; ++q) { const int row = row0 + q * TNW; if (row < 2 * NEXP) {
                    unsigned char* dst = (row < NEXP) ? UTAB + (size_t)row * DM : VTAB + (size_t)(row - NEXP) * DM; float mx = 0.f;
#pragma unroll
                    for (int j = 0; j < 4; ++j) mx = fmaxf(mx, fmaxf(fmaxf(fabsf(v[q][j][0]), fabsf(v[q][j][1])), fmaxf(fabsf(v[q][j][2]), fabsf(v[q][j][3]))));
#pragma unroll
                    for (int o = 1; o < 64; o <<= 1) mx = fmaxf(mx, __shfl_xor(mx, o));
                    const int E = (int)((__builtin_bit_cast(unsigned, mx) >> 23) & 0xFFu);
                    int k = E - 134; k = (E == 0) ? 0 : k; k = k < -100 ? -100 : (k > 100 ? 100 : k);
                    const float sinv = __builtin_bit_cast(float, (unsigned)(127 - k) << 23);
                    u32x4 w;
#pragma unroll
                    for (int j = 0; j < 4; ++j) { int p = 0; p = __builtin_amdgcn_cvt_pk_fp8_f32(v[q][j][0] * sinv, v[q][j][1] * sinv, p, false); p = __builtin_amdgcn_cvt_pk_fp8_f32(v[q][j][2] * sinv, v[q][j][3] * sinv, p, true); w[j] = (unsigned)p; }
                    *((u32x4*)dst + lane) = w;
                    if (lane == 0) { if (row < NEXP) EXPU[row] = k + 128; else EXPV[row - NEXP] = k + 128; } } }
            }
        }
    } }

    SEAM(1);
    if (IN(2)) { for (int rep_ = 0; rep_ < (((REP_MASK) >> 2) & 1) + 1; ++rep_) { if (rep_) grid_.sync();
        constexpr int NCT = NTOK / 32;
        if (bx < 128) {
            const int g = bx >> 2, pn = bx & 3;
            {
                pg8::Gemm gm{256, 256, KX}; pg8::OneUnit S; S.valid = 1; S.u.pm = 0; S.u.pn = pn;
                S.u.A = (const char*)(W1EXT + (size_t)g * 256 * 256); S.u.B = (const char*)(UEXT + ((size_t)g * NCH + pn * 256) * KX);
                EpiScan E{LPOW, UEXT, g, pn};
                pg8::gemm_phase<EpiScan, pg8::OneUnit, false>(lds, gm, S, E, wave0);
            }
            VM_WAIT(); __syncthreads();
            if (T0_()) { __builtin_amdgcn_fence(__ATOMIC_ACQUIRE, "agent"); asm volatile("s_waitcnt vmcnt(0)" ::: "memory"); }
            __syncthreads();
            {
                pg8::Gemm gm{KX, KX, KX}; pg8::OneUnit S; S.valid = 1; S.u.pm = pn; S.u.pn = 0;
                S.u.A = (const char*)(UEXT + ((size_t)g * NCH + pn * 256) * KX); S.u.B = (const char*)(KEXT + (size_t)g * 256 * KX);
                EpiGlu E{PAR + PO_GLUW, PAR + PO_GLUB, YCAT, g, pn};
                pg8::gemm_phase<EpiGlu, pg8::OneUnit, false>(lds, gm, S, E, wave0);
            }
            __syncthreads();
            conv_tiles<32>(lds, PAR, HCONV, YCAT, bx, bx + 1, 1, wave0);
        } else {
            const int nb = G - 128, per = (NCT - 128 + nb - 1) / nb, f0 = 128 + (bx - 128) * per, f1 = (f0 + per) < NCT ? (f0 + per) : NCT;
            conv_tiles<32>(lds, PAR, HCONV, YCAT, f0, f1, 1, wave0);
        }
    } }

    SEAM(3);
    if (IN(4)) { for (int rep_ = 0; rep_ < (((REP_MASK) >> 4) & 1) + 1; ++rep_) { if (rep_) grid_.sync();
        pg8::Gemm g{DM, DM, DM}; pg8::GridOrder S; S.init(YCAT, WOUT, DM, DM, NTOK, DM, G, bx);
        CArgs* pa = ap; asm volatile("" : "+s"(pa));
        EpiRes E{pa->in[I_X], X1, XB, SSQ2};
        pg8::gemm_phase<EpiRes, pg8::GridOrder, true>(lds, g, S, E, wave0);
    } }

    SEAM(4);
    if (IN(5)) { {
        pg8::GridOrder S5o; S5o.init(XB, WQK, DM, DM, NTOK, NQ, G, bx);
        for (int i = 0; ; ++i) {
            pg8::OneUnit S; S.valid = 1; if (!S5o.next(i, S.u)) break;
            pg8::Gemm gm{DM, DM, DM};
            EpiTopk E{SSQ2, SELE, SELG};
            pg8::gemm_phase<EpiTopk, pg8::OneUnit, false>(lds, gm, S, E, wave0);
            __syncthreads();
        }
    } }

    SEAM(6);
    if (IN(7)) { for (int rep_ = 0; rep_ < (((REP_MASK) >> 7) & 1) + 1; ++rep_) { if (rep_) { __syncthreads(); }
        PH_IDS();
        constexpr int TPW = 8, SHU = 11, NSLABU = NEXP >> SHU, RS = 16, NIT = TPW * 128, ROWB = 1024, USLOT = 1056, NGRP = NIT / 8;
        LAS unsigned char* WL = lds + wave * 20480;
        LAS unsigned short* ORD = (LAS unsigned short*)WL;
        LAS unsigned char* OWN = WL + 2048;
        LAS unsigned char* RINGU = WL + 3072;
        LAS unsigned char* RING = WL + 3072;
        LAS float* DOT = (LAS float*)(WL + 3072);
#define G_WAITV(n) asm volatile("s_waitcnt vmcnt(" #n ")" ::: "memory")
        for (int tg = gw; tg < NTOK / TPW; tg += NGW) {
            int lane; asm volatile("v_mbcnt_lo_u32_b32 %0, -1, 0\n\tv_mbcnt_hi_u32_b32 %0, -1, %0" : "=&v"(lane));
            const int t0 = tg * TPW;
            int e_lo[TPW], e_hi[TPW], kx[TPW];
            {
                const f32x4* gr = (const f32x4*)(PAR + PO_G2) + 4 * lane;
                const f32x4 g2a = gr[0], g2b = gr[1], g2c = gr[2], g2d = gr[3];
#pragma unroll
                for (int i = 0; i < TPW; ++i) {
                    const int tok = t0 + i;
                    const u32x4* xr = (const u32x4*)(XB + (size_t)tok * DM) + 2 * lane;
                    const u32x4 xa = xr[0], xb = xr[1];
                    const f32x4 a0 = (f32x4){bf2f(xa[0] & 0xFFFFu), bf2f(xa[0] >> 16), bf2f(xa[1] & 0xFFFFu), bf2f(xa[1] >> 16)}, a1 = (f32x4){bf2f(xa[2] & 0xFFFFu), bf2f(xa[2] >> 16), bf2f(xa[3] & 0xFFFFu), bf2f(xa[3] >> 16)};
                    const f32x4 a2 = (f32x4){bf2f(xb[0] & 0xFFFFu), bf2f(xb[0] >> 16), bf2f(xb[1] & 0xFFFFu), bf2f(xb[1] >> 16)}, a3 = (f32x4){bf2f(xb[2] & 0xFFFFu), bf2f(xb[2] >> 16), bf2f(xb[3] & 0xFFFFu), bf2f(xb[3] >> 16)};
                    float ps = (lane < 16) ? SSQ2[(size_t)tok * 16 + lane] : 0.f; ps = wave_sum_dpp(ps);
                    const float rs = rsqrtf(ps * (1.0f / DM) + EPS);
                    f32x4 b[4]; b[0] = a0 * g2a * rs; b[1] = a1 * g2b * rs; b[2] = a2 * g2c * rs; b[3] = a3 * g2d * rs;
                    float mx = 0.f;
#pragma unroll
                    for (int j = 0; j < 4; ++j) mx = fmaxf(mx, fmaxf(fmaxf(fabsf(b[j][0]), fabsf(b[j][1])), fmaxf(fabsf(b[j][2]), fabsf(b[j][3]))));
                    mx = wave_max_dpp(mx);
                    const int E = (int)((__builtin_bit_cast(unsigned, mx) >> 23) & 0xFFu);
                    int k = E - 134; k = (E == 0) ? 0 : k; k = k < -100 ? -100 : (k > 100 ? 100 : k);
                    kx[i] = __builtin_amdgcn_readfirstlane(k);
                    const float sinv = __builtin_bit_cast(float, (unsigned)(127 - k) << 23);
                    u32x4 wq;
#pragma unroll
                    for (int j = 0; j < 4; ++j) { int p = 0; p = __builtin_amdgcn_cvt_pk_fp8_f32(b[j][0] * sinv, b[j][1] * sinv, p, false); p = __builtin_amdgcn_cvt_pk_fp8_f32(b[j][2] * sinv, b[j][3] * sinv, p, true); wq[j] = (unsigned)p; }
                    *(LAS u32x4*)(RINGU + i * 1024 + lane * 16) = wq;
                    e_lo[i] = SELE[(size_t)tok * 128 + lane]; e_hi[i] = SELE[(size_t)tok * 128 + 64 + lane];
                }
            }
            int p_lo[TPW], p_hi[TPW];
            {
                int running = 0;
#pragma unroll
                for (int i = 0; i < TPW; ++i) { e_lo[i] |= (EXPU[e_lo[i]] << 14) | (EXPV[e_lo[i]] << 22); e_hi[i] |= (EXPU[e_hi[i]] << 14) | (EXPV[e_hi[i]] << 22); asm volatile("" : "+v"(e_lo[i]), "+v"(e_hi[i])); p_lo[i] = 0; p_hi[i] = 0; }
                for (int sl = 0; sl < NSLABU; ++sl) {
#pragma unroll
                    for (int i = 0; i < TPW; ++i) {
                        const int ls = (e_lo[i] & 0x3FFF) >> SHU, hs = (e_hi[i] & 0x3FFF) >> SHU;
                        const unsigned long long ml = __ballot(ls == sl), mh = __ballot(hs == sl);
                        const int cl = __popcll(ml);
                        const int rl = (int)__builtin_amdgcn_mbcnt_hi((unsigned)(ml >> 32), __builtin_amdgcn_mbcnt_lo((unsigned)ml, 0u)), rh = (int)__builtin_amdgcn_mbcnt_hi((unsigned)(mh >> 32), __builtin_amdgcn_mbcnt_lo((unsigned)mh, 0u));
                        p_lo[i] = (ls == sl) ? running + rl : p_lo[i]; p_hi[i] = (hs == sl) ? running + cl + rh : p_hi[i];
                        running += cl + __popcll(mh);
                    }
                }
#pragma unroll
                for (int i = 0; i < TPW; ++i) { ORD[p_lo[i]] = (unsigned short)(e_lo[i] & 0x3FFF); OWN[p_lo[i]] = (unsigned char)i; ORD[p_hi[i]] = (unsigned short)(e_hi[i] & 0x3FFF); OWN[p_hi[i]] = (unsigned char)i; }
            }
            VM_WAIT(); LDS_WAIT(); asm volatile("" ::: "memory");
            {
                int lane_u = lane; asm volatile("" : "+v"(lane_u));
                const int mq = lane_u & 15, q = lane_u >> 4;
                const int chq = 16 * (q & 1) + 8 * (q >> 1);
                i32x8 Bx[2][4];
#pragma unroll
                for (int hh = 0; hh < 2; ++hh)
#pragma unroll
                    for (int st = 0; st < 4; ++st) {
                        const LAS unsigned char* xp = RINGU + (mq & 7) * 1024 + 512 * hh + 16 * (chq + 2 * st);
                        const i32x4 b0 = *(const LAS i32x4*)xp, b1 = *(const LAS i32x4*)(xp + 16);
                        Bx[hh][st] = (i32x8){b0[0], b0[1], b0[2], b0[3], b1[0], b1[1], b1[2], b1[3]};
                    }
                asm volatile("s_waitcnt lgkmcnt(0)" ::: "memory");
                const int ab = (mq >> 1) * USLOT + 512 * (mq & 1) + 16 * (chq + (mq & 1));
                const int ab7 = ab + 112 - ((q == 3 && (mq & 1)) ? 512 : 0);
                const unsigned srcoffu0 = 16u * (unsigned)(((lane_u & 31) - (lane_u >> 5)) & 31);
                LAS float* STG = (LAS float*)(WL + 19968);
                float dflat[16];
#pragma unroll
                for (int r = 0; r < 16; ++r) dflat[r] = 0.f;
                const LAS unsigned short* ordl = ORD + (lane_u >> 5);
#define U_LIST(EV_, G_) do { const int gq_ = (G_) < 63 ? (G_) : 63; _Pragma("unroll") for (int k_ = 0; k_ < 8; ++k_) EV_[k_] = ordl[16 * gq_ + 2 * k_]; } while (0)
#define U_LOADS(EV_, HALF_) do { _Pragma("unroll") for (int k_ = 0; k_ < 8; ++k_) { const unsigned off_ = ((unsigned)EV_[k_] << 10) | srcoffu; \
                    __builtin_amdgcn_global_load_lds((const unsigned*)(UTAB + off_), (LAS unsigned*)(RINGU + (8 * (HALF_) + k_) * USLOT), 16, 0, 0); } } while (0)
#pragma unroll
                for (int hh = 0; hh < 2; ++hh) {
                    const unsigned srcoffu = srcoffu0 + 512u * (unsigned)hh;
                    VM_WAIT();
                    { unsigned short ev0[8], ev1[8]; U_LIST(ev0, 0); U_LIST(ev1, 1); LDS_WAIT(); U_LOADS(ev0, 0); U_LOADS(ev1, 1); }
#pragma unroll
                    for (int r = 0; r < 16; ++r) {
                        for (int gg = 0; gg < 4; ++gg) {
                            const int G = 4 * r + gg;
                            unsigned short ev[8]; U_LIST(ev, G + 2);
                            const unsigned own4 = *(const LAS unsigned*)(OWN + 16 * G + 4 * q);
                            G_WAITV(8);
                            const LAS unsigned char* rbu = RINGU + (gg & 1) * (8 * USLOT);
                            i32x8 A[4];
#pragma unroll
                            for (int st = 0; st < 4; ++st) {
                                const i32x4 a0 = *(const LAS i32x4*)(rbu + ab + 32 * st), a1 = (st < 3) ? *(const LAS i32x4*)(rbu + ab + 32 * st + 16) : *(const LAS i32x4*)(rbu + ab7);
                                A[st] = (i32x8){a0[0], a0[1], a0[2], a0[3], a1[0], a1[1], a1[2], a1[3]};
                            }
                            LDS_WAIT();
                            U_LOADS(ev, gg & 1);
                            f32x4 acc4 = (f32x4){0.f, 0.f, 0.f, 0.f};
#pragma unroll
                            for (int st = 0; st < 4; ++st) acc4 = __builtin_amdgcn_mfma_scale_f32_16x16x128_f8f6f4(A[st], Bx[hh][st], acc4, 0, 0, 0, 0x7F7F7F7F, 0, 0x7F7F7F7F);
#pragma unroll
                            for (int j = 0; j < 4; ++j) {
                                const float accj = acc4[j];
                                if ((int)((own4 >> (8 * j)) & 0xFFu) == mq) STG[16 * gg + 4 * q + j] = accj;
                            }
                        }
                        LDS_WAIT();
                        dflat[r] += STG[lane_u];
                    }
                }
#undef U_LIST
#undef U_LOADS
                VM_WAIT();
#pragma unroll
                for (int r = 0; r < 16; ++r) DOT[64 * r + lane] = dflat[r];
                LDS_WAIT(); asm volatile("" ::: "memory");
            }
            float w_lo[TPW], w_hi[TPW];
            {
#pragma unroll
                for (int i = 0; i < TPW; ++i) {
                    const int tok = t0 + i;
                    const float slo = __builtin_bit_cast(float, (unsigned)(((e_lo[i] >> 14) & 0xFF) + kx[i] - 1) << 23), shi = __builtin_bit_cast(float, (unsigned)(((e_hi[i] >> 14) & 0xFF) + kx[i] - 1) << 23);
                    w_lo[i] = SELG[(size_t)tok * 128 + lane] * gelu1(DOT[p_lo[i]] * slo); w_hi[i] = SELG[(size_t)tok * 128 + 64 + lane] * gelu1(DOT[p_hi[i]] * shi);
                }
            }
            unsigned ORDR[8];
#pragma unroll
            for (int v = 0; v < 8; ++v) ORDR[v] = ((const LAS unsigned*)ORD)[64 * v + lane];
            LDS_WAIT(); asm volatile("" ::: "memory");
            LAS unsigned char* WQ = WL;
            int kw[TPW];
#pragma unroll
            for (int i = 0; i < TPW; ++i) {
                const float sl_ = __builtin_bit_cast(float, (unsigned)(((e_lo[i] >> 22) & 0xFF) - 1) << 23), sh_ = __builtin_bit_cast(float, (unsigned)(((e_hi[i] >> 22) & 0xFF) - 1) << 23);
                const float wl = w_lo[i] * sl_, wh = w_hi[i] * sh_;
                float mx = fmaxf(fabsf(wl), fabsf(wh));
                mx = wave_max_dpp(mx);
                const int E = (int)((__builtin_bit_cast(unsigned, mx) >> 23) & 0xFFu);
                int k = E - 134; k = (E == 0) ? 0 : k; k = k < -100 ? -100 : (k > 100 ? 100 : k);
                kw[i] = __builtin_amdgcn_readfirstlane(k);
                const float sinv = __builtin_bit_cast(float, (unsigned)(127 - k) << 23);
                const float al = wl * sinv, ah = wh * sinv;
                const int ph = __builtin_amdgcn_cvt_pk_fp8_f32(al, ah, 0, false);
                const float fl = __builtin_amdgcn_cvt_f32_fp8(ph, 0), fh = __builtin_amdgcn_cvt_f32_fp8(ph, 1);
                const int pl = __builtin_amdgcn_cvt_pk_fp8_f32(al - fl, ah - fh, 0, false);
                WQ[p_lo[i]] = (unsigned char)(ph & 0xFF); WQ[p_hi[i]] = (unsigned char)((ph >> 8) & 0xFF);
                WQ[1024 + p_lo[i]] = (unsigned char)(pl & 0xFF); WQ[1024 + p_hi[i]] = (unsigned char)((pl >> 8) & 0xFF);
            }
            VM_WAIT(); LDS_WAIT(); asm volatile("" ::: "memory");
            {
                int lane_v = lane; asm volatile("" : "+v"(lane_v));
                const int nq = lane_v & 15, kq = lane_v >> 4;
                const int rho = 8 * (kq & 1) + (nq >> 1), hb = rho & 1;
                const int lb = (rho >> 1) * USLOT + 528 * hb + 8 * (nq & 1);
                const int lb31 = lb + 496 - 512 * hb;
                const unsigned srcoff0 = 16u * (unsigned)(((lane_v & 31) - (lane_v >> 5)) & 31);
                const unsigned shv = 16u * (unsigned)(lane_v >> 5);
                float tsc = 0.f;
#pragma unroll
                for (int i = 0; i < TPW; ++i) tsc = ((nq & 7) == i) ? __builtin_bit_cast(float, (unsigned)(127 + kw[i]) << 23) : tsc;
                const unsigned long long nrep = 0x0101010101010101ull * (unsigned long long)nq;
                const int wqoff = ((kq & 2) ? 1024 : 0) + 8 * (kq & 1);
                float ssq = 0.f;
                u32x2 stash[16];
                float* x1p = X1; asm volatile("" : "+s"(x1p));
                const bf16_t* xbp = XB; asm volatile("" : "+s"(xbp));
                const float* par2 = PAR; asm volatile("" : "+s"(par2));
#define V_ISSUE(SRC_, L0_, HALF_) do { const int l0_ = (L0_); \
                _Pragma("unroll") for (int k_ = 0; k_ < 8; ++k_) { const unsigned wd_ = (unsigned)__builtin_amdgcn_readlane((int)(SRC_), l0_ + k_); \
                    const unsigned off_ = (__builtin_amdgcn_ubfe(wd_, shv, 16) << 10) | srcoff; \
                    __builtin_amdgcn_global_load_lds((const unsigned*)(VTAB + off_), (LAS unsigned*)(RINGU + (8 * (HALF_) + k_) * USLOT), 16, 0, 0); } } while (0)
                for (int h = 0; h < 2; ++h) {
                    const unsigned srcoff = srcoff0 + 512u * (unsigned)h;
                    f32x4 acc[32];
#pragma unroll
                    for (int T = 0; T < 32; ++T) acc[T] = (f32x4){0.f, 0.f, 0.f, 0.f};
                    VM_WAIT();
                    V_ISSUE(ORDR[0], 0, 0); V_ISSUE(ORDR[0], 8, 1);
#pragma unroll
                    for (int v = 0; v < 8; ++v) {
                        for (int j = 0; j < 8; ++j) {
                            const int b = 8 * v + j;
                            G_WAITV(8);
                            const LAS unsigned char* rb = RINGU + (j & 1) * (8 * USLOT);
#define V_READ8(A_, tb_) do { _Pragma("unroll") for (int T = 0; T < 8; ++T) A_[T] = __builtin_bit_cast(long, __builtin_amdgcn_ds_read_tr8_b64_v2i32((LAS i32x2*)((8 * (tb_) + T) < 31 ? rb + lb + 16 * (8 * (tb_) + T) : rb + lb31))); } while (0)
                            long A[8];
                            V_READ8(A, 0);
                            const unsigned long long wq = *(const LAS unsigned long long*)(WQ + wqoff + 16 * b);
                            const unsigned long long ow = *(const LAS unsigned long long*)(OWN + 8 * (kq & 1) + 16 * b);
                            const unsigned long long xo = ow ^ nrep;
                            const unsigned x0 = (unsigned)xo, x1 = (unsigned)(xo >> 32);
                            const unsigned n0 = (x0 + 0x7F7F7F7Fu) & 0x80808080u, n1 = (x1 + 0x7F7F7F7Fu) & 0x80808080u;
                            const unsigned m0 = n0 | (n0 - (n0 >> 7)), m1 = n1 | (n1 - (n1 >> 7));
                            const long B = (long)(((unsigned long long)((unsigned)(wq >> 32) & ~m1) << 32) | (unsigned long long)((unsigned)wq & ~m0));
#pragma unroll
                            for (int tb = 0; tb < 4; ++tb) {
                                if (tb > 0) V_READ8(A, tb);
                                if (tb == 3) {
                                    LDS_WAIT();
                                    const bool last = (v == 7) && (j >= 6); const unsigned src = (j < 6 || v == 7) ? ORDR[v] : ORDR[v < 7 ? v + 1 : 7];
                                    V_ISSUE(src, last ? 56 : ((8 * (j + 2)) & 63), j & 1);
                                }
#pragma unroll
                                for (int T = 0; T < 8; ++T) acc[8 * tb + T] = __builtin_amdgcn_mfma_f32_16x16x32_fp8_fp8(A[T], B, acc[8 * tb + T], 0, 0, 0);
                            }
#undef V_READ8
                        }
                    }
                    {
                        const int tok = t0 + (nq & 7);
                        const int cofs = 16 * (nq >> 3) + 4 * kq;
                        const bf16_t* xrow = xbp + (size_t)tok * DM + 512 * h + cofs;
#pragma unroll
                        for (int t = 0; t < 16; ++t) {
                            f32x4 mg;
#pragma unroll
                            for (int r = 0; r < 4; ++r) { const float ev = acc[2 * t][r], od = acc[2 * t + 1][r];
                                mg[r] = __builtin_bit_cast(float, __builtin_amdgcn_update_dpp(__builtin_bit_cast(int, ev), __builtin_bit_cast(int, od), 0x128, 0xF, 0xC, false)); }
                            const u32x2 xq = *(const u32x2*)(xrow + 32 * t);
                            const f32x4 o = (f32x4){bf2f(xq.x & 0xFFFFu), bf2f(xq.x >> 16), bf2f(xq.y & 0xFFFFu), bf2f(xq.y >> 16)} + mg * tsc;
                            ssq += (o[0] * o[0] + o[1] * o[1]) + (o[2] * o[2] + o[3] * o[3]);
                            acc[2 * t] = o;
                            if ((t & 3) == 3) asm volatile("" ::: "memory");
                        }
                        if (h == 0) {
#pragma unroll
                            for (int t = 0; t < 16; ++t) { stash[t].x = cvt_pk_bf16_c(acc[2 * t][0], acc[2 * t][1]); stash[t].y = cvt_pk_bf16_c(acc[2 * t][2], acc[2 * t][3]); }
                        } else {
                            float tot = 0.f;
#pragma unroll
                            for (int i = 0; i < TPW; ++i) { const float ti = wave_sum_dpp(((nq & 7) == i) ? ssq : 0.f); tot = ((nq & 7) == i) ? ti : tot; }
                            const float rf = rsqrtf(tot * (1.0f / DM) + EPS);
                            float* orow = x1p + (size_t)tok * DM + cofs;
                            const float* fgp = par2 + PO_FG + cofs;
#pragma unroll
                            for (int t = 0; t < 16; ++t) {
                                const f32x4 o0 = (f32x4){bf2f(stash[t].x & 0xFFFFu), bf2f(stash[t].x >> 16), bf2f(stash[t].y & 0xFFFFu), bf2f(stash[t].y >> 16)};
                                *(f32x4*)(orow + 32 * t) = o0 * rf * *(const f32x4*)(fgp + 32 * t);
                                *(f32x4*)(orow + 512 + 32 * t) = acc[2 * t] * rf * *(const f32x4*)(fgp + 512 + 32 * t);
                                if ((t & 3) == 3) asm volatile("" ::: "memory");
                            }
                        }
                    }
                }
#undef V_ISSUE
            }
        }
        VM_WAIT();
#undef G_WAITV
    } }
#undef IN
}

extern "C" void kernel_launch(void* const* d_in, const int* in_sizes, int n_in, void* d_out, int out_size, void* d_ws, size_t ws_size, hipStream_t stream) {
    static int grid = 0;
    if (grid == 0) {
        if (n_in != 25 || out_size != NTOK * DM || ws_size < WS_END) { fprintf(stderr, "kernel_launch: unexpected shapes (n_in %d, out %d, ws %zu)\n", n_in, out_size, ws_size); grid = -1; return; }
        int dev = 0, cus = 0;
        if (hipGetDevice(&dev) != hipSuccess || hipDeviceGetAttribute(&cus, hipDeviceAttributeMultiprocessorCount, dev) != hipSuccess) { grid = -1; return; }
        if (hipFuncSetAttribute((const void*)fwd_kernel, hipFuncAttributeMaxDynamicSharedMemorySize, LDS_BYTES) != hipSuccess) { fprintf(stderr, "kernel_launch: hipFuncSetAttribute failed\n"); grid = -1; return; }
        int per_cu = 0;
        if (hipOccupancyMaxActiveBlocksPerMultiprocessor(&per_cu, (const void*)fwd_kernel, NTHR, LDS_BYTES) != hipSuccess || per_cu < 1) { fprintf(stderr, "kernel_launch: occupancy query failed (%d)\n", per_cu); grid = -1; return; }
        grid = cus;
    }
    if (grid < 0) return;
    Args a{};
    for (int i = 0; i < 25; ++i) a.in[i] = (const float*)d_in[i];
    a.out = (float*)d_out; a.ws = (unsigned char*)d_ws;
    a.ph_lo = 0; a.ph_hi = 8;
    if (hipMemsetAsync((char*)d_ws + WS_CTL, 0, 32768, stream) != hipSuccess) { fprintf(stderr, "kernel_launch: memset of the barrier words failed\n"); return; }
    void* kargs[] = {&a};
    hipError_t e = hipLaunchCooperativeKernel((const void*)fwd_kernel, dim3(grid), dim3(NTHR), kargs, LDS_BYTES, stream);
    if (e != hipSuccess) fprintf(stderr, "kernel_launch: cooperative launch failed: %s (grid %d)\n", hipGetErrorString(e), grid);
}
```

```cpp
#include <hip/hip_runtime.h>
#include <hip/hip_cooperative_groups.h>
#include <cstdio>
#include <cstdint>

#define LAS __attribute__((address_space(3)))
typedef unsigned short bf16_t;
typedef short bf16x8 __attribute__((ext_vector_type(8)));
typedef float f32x4 __attribute__((ext_vector_type(4)));
typedef float f32x2 __attribute__((ext_vector_type(2)));
typedef unsigned u32x4 __attribute__((ext_vector_type(4)));
typedef unsigned u32x2 __attribute__((ext_vector_type(2)));
typedef int i32x2 __attribute__((ext_vector_type(2)));
typedef int i32x4 __attribute__((ext_vector_type(4)));
typedef int i32x8 __attribute__((ext_vector_type(8)));
typedef __bf16 bf16x2_t __attribute__((ext_vector_type(2)));

constexpr int NTOK = 16384, DM = 1024, SEQ = 2048;
constexpr int NG = 32, GH = 16, NP = 64, CHK = 16, NCH = NTOK / CHK  , KX = 384  ;
constexpr int NQ = 2048, NEXP = 16384;
constexpr float EPS = 1e-6f;
constexpr int NWAVES = 8, NTHR = 512;
constexpr int LDS_BYTES = 163840;

constexpr size_t MiB = 1u << 20;
constexpr size_t WS_CTL = 0;
constexpr size_t WS_WIN = 1 * MiB;
constexpr size_t WS_WOUT = 4 * MiB;
constexpr size_t WS_WQ = 6 * MiB;
constexpr size_t WS_KEXT = 10 * MiB;
constexpr size_t WS_W1EXT = 16 * MiB;
constexpr size_t WS_KBLK = 20 * MiB;
constexpr size_t WS_LPOW = 20 * MiB + 128 * 1024;
constexpr size_t WS_RSTD1 = 20 * MiB + 192 * 1024;
constexpr size_t WS_PAR = 20 * MiB + 256 * 1024;
constexpr int PO_CW = 0, PO_CB = 31 * 512, PO_LNG = PO_CB + 512, PO_LNB = PO_LNG + 512, PO_GLUW = PO_LNB + 512, PO_GLUB = PO_GLUW + 8192, PO_G2 = PO_GLUB + 512, PO_FG = PO_G2 + 1024, PO_END = PO_FG + 1024;
constexpr size_t WS_SSQ2 = 21 * MiB;
constexpr size_t WS_SELE = 22 * MiB;
constexpr size_t WS_SELG = 30 * MiB;
constexpr size_t WS_UTAB = 38 * MiB;
constexpr size_t WS_VTAB = 54 * MiB;
constexpr size_t WS_EXPU = 70 * MiB;
constexpr size_t WS_EXPV = 70 * MiB + 65536;
constexpr size_t WS_XB = 102 * MiB;
constexpr size_t WS_UEXT = 134 * MiB;
constexpr size_t WS_HCONV = 158 * MiB;
constexpr size_t WS_YCAT = 174 * MiB;
constexpr size_t WS_WQK = 206 * MiB;
constexpr size_t WS_END = 210 * MiB;

__device__ __forceinline__ unsigned cvt_pk_bf16(float lo, float hi) { unsigned r; asm volatile("v_cvt_pk_bf16_f32 %0, %1, %2" : "=v"(r) : "v"(lo), "v"(hi)); return r; }
__device__ __forceinline__ unsigned cvt_pk_bf16_c(float lo, float hi) { const f32x2 v = {lo, hi}; const bf16x2_t b = __builtin_convertvector(v, bf16x2_t); return __builtin_bit_cast(unsigned, b); }
__device__ __forceinline__ unsigned f2bf(float f) { unsigned u = __builtin_bit_cast(unsigned, f); return (u + 0x7fffu + ((u >> 16) & 1u)) >> 16; }
__device__ __forceinline__ float bf2f(unsigned b) { return __builtin_bit_cast(float, b << 16); }
__device__ __forceinline__ float wave_sum(float v) {
#pragma unroll
    for (int o = 1; o < 64; o <<= 1) v += __shfl_xor(v, o);
    return v;
}
template <int CTRL> __device__ __forceinline__ float dpp_f(float x) { return __builtin_bit_cast(float, __builtin_amdgcn_update_dpp(0, __builtin_bit_cast(int, x), CTRL, 0xf, 0xf, true)); }
__device__ __forceinline__ float wave_sum_dpp(float v) {
    v += dpp_f<0xB1>(v); v += dpp_f<0x4E>(v); v += dpp_f<0x141>(v); v += dpp_f<0x140>(v);
    v += __builtin_bit_cast(float, __builtin_amdgcn_update_dpp(0, __builtin_bit_cast(int, v), 0x142, 0xa, 0xf, false));
    v += __builtin_bit_cast(float, __builtin_amdgcn_update_dpp(0, __builtin_bit_cast(int, v), 0x143, 0xc, 0xf, false));
    return __builtin_bit_cast(float, __builtin_amdgcn_readlane(__builtin_bit_cast(int, v), 63));
}
__device__ __forceinline__ float wave_max_dpp(float v) {
    v = fmaxf(v, dpp_f<0xB1>(v)); v = fmaxf(v, dpp_f<0x4E>(v)); v = fmaxf(v, dpp_f<0x141>(v)); v = fmaxf(v, dpp_f<0x140>(v));
    v = fmaxf(v, __builtin_bit_cast(float, __builtin_amdgcn_update_dpp(0, __builtin_bit_cast(int, v), 0x142, 0xa, 0xf, false)));
    v = fmaxf(v, __builtin_bit_cast(float, __builtin_amdgcn_update_dpp(0, __builtin_bit_cast(int, v), 0x143, 0xc, 0xf, false)));
    return __builtin_bit_cast(float, __builtin_amdgcn_readlane(__builtin_bit_cast(int, v), 63));
}
__device__ __forceinline__ float sigmoidf_(float x) { return __builtin_amdgcn_rcpf(1.0f + __expf(-x)); }
__device__ __forceinline__ f32x2 gelu_pk(f32x2 v) {
    const f32x2 av = __builtin_elementwise_abs(v), d = av * 0.2316418882f + 1.0f;
    f32x2 t; t.x = __builtin_amdgcn_rcpf(d.x); t.y = __builtin_amdgcn_rcpf(d.y);
    f32x2 q = t * 0.5307027145f + (-0.7265760135f); q = q * t + 0.7107068705f; q = q * t + (-0.142248368f); q = q * t + 0.127414796f; q = q * t;
    const f32x2 s = (v * v) * (-0.72134752044f);
    f32x2 e; e.x = __builtin_amdgcn_exp2f(s.x); e.y = __builtin_amdgcn_exp2f(s.y);
    const f32x2 m = v * (q * e), r = v - m;
    f32x2 o; o.x = v.x < 0.f ? m.x : r.x; o.y = v.y < 0.f ? m.y : r.y; return o;
}
__device__ __forceinline__ float gelu1(float x) { f32x2 r = gelu_pk((f32x2){x, x}); return r.x; }
__device__ __forceinline__ float dot2_bf16(unsigned w, unsigned x, float acc) { return __builtin_amdgcn_fdot2_f32_bf16(__builtin_bit_cast(bf16x2_t, w), __builtin_bit_cast(bf16x2_t, x), acc, false); }
template <int S> __device__ __forceinline__ float ror16f(float x) { return __builtin_bit_cast(float, __builtin_amdgcn_update_dpp(0, __builtin_bit_cast(int, x), 0x120 + S, 0xf, 0xf, false)); }
template <int S> __device__ __forceinline__ int ror16i(int x) { return __builtin_amdgcn_update_dpp(0, x, 0x120 + S, 0xf, 0xf, false); }
__device__ __forceinline__ int lane_id_() { return (int)__builtin_amdgcn_mbcnt_hi(~0u, __builtin_amdgcn_mbcnt_lo(~0u, 0u)); }
#define LDS_WAIT() asm volatile("s_waitcnt lgkmcnt(0)" ::: "memory")
#define VM_WAIT() asm volatile("s_waitcnt vmcnt(0)" ::: "memory")

namespace pg8 {
constexpr int BM = 256, BK = 64, HALF = 128, HTB = HALF * BK * 2, STAGE_BYTES = 8 * HTB;
__host__ __device__ __forceinline__ int lds_byte(int r, int c) { const int st = (r >> 4) * 2 + (c >> 5), rr = r & 15, cc = c & 31, ob = rr * 64 + cc * 2; return st * 1024 + (ob ^ (((ob >> 9) & 1) << 5)); }
__host__ __device__ __forceinline__ void stage_rc(int b, int& R, int& C) { const int st = b / 1024, sb = b % 1024, swz = sb ^ (((sb >> 9) & 1) << 5); R = (st >> 1) * 16 + swz / 64; C = (st & 1) * 32 + (swz % 64) / 2; }
__host__ __device__ __forceinline__ int perm32(int rho) { const int n = rho >> 4, i = rho & 15; return 8 * (i >> 2) + 4 * n + (i & 3); }

struct Unit { const char* A; const char* B; int pm, pn; };
struct Gemm { int K, lda, ldb; };

template <class Epi, class Sched, bool ALIGN_EPI>
__device__ __forceinline__ void gemm_phase(LAS unsigned char* lds, const Gemm g, const Sched& S, const Epi& E, const int wave0) {
    int tid = (wave0 << 6) | lane_id_(); asm volatile("" : "+v"(tid));
    const int wid = __builtin_amdgcn_readfirstlane(tid >> 6), lane = tid & 63, wr = wid >> 2, wc = wid & 3, fr = lane & 15, fq = lane >> 4;
    const int K = g.K, nt = K / BK;
    unsigned voffA[2], voffB[2];
#pragma unroll
    for (int i = 0; i < 2; ++i) { int R, C; stage_rc(tid * 16 + i * 8192, R, C); const int Rb = Epi::PERM ? ((R & ~31) + perm32(R & 31)) : R;
        voffA[i] = (unsigned)(R * g.lda + C) * 2u; voffB[i] = (unsigned)(Rb * g.ldb + C) * 2u; }
    const size_t kstep = (size_t)(BK * 2);
    const size_t hstepA = (size_t)HALF * g.lda * 2, hstepB = (size_t)HALF * g.ldb * 2;
    const unsigned ldsw = (unsigned)wid * 1024u;
    const int aoff = lds_byte(wr * 64 + fr, fq * 8), boff = lds_byte(wc * 32 + fr, fq * 8);
#define PG8_SA(b, h) (((b) * 2 + (h)) * HTB)
#define PG8_SB(b, h) ((4 + (b) * 2 + (h)) * HTB)
#define PG8_STAGE(bufoff, gbase, voff) do { _Pragma("unroll") for (int _i = 0; _i < 2; ++_i) \
        __builtin_amdgcn_global_load_lds((const unsigned*)((const char*)(gbase) + (voff)[_i]), (LAS unsigned*)(lds + (bufoff) + ldsw + _i * 8192), 16, 0, 0); } while (0)
#define PG8_LDA(dst, b, h) do { _Pragma("unroll") for (int m = 0; m < 4; ++m) _Pragma("unroll") for (int k = 0; k < 2; ++k) dst[m][k] = *(const LAS bf16x8*)(lds + PG8_SA(b, h) + aoff + m * 2048 + k * 1024); } while (0)
#define PG8_LDB(dst, b, h) do { _Pragma("unroll") for (int n = 0; n < 2; ++n) _Pragma("unroll") for (int k = 0; k < 2; ++k) dst[n][k] = *(const LAS bf16x8*)(lds + PG8_SB(b, h) + boff + n * 2048 + k * 1024); } while (0)
#define PG8_MMA(ai, bj, At, Bt) do { __builtin_amdgcn_s_setprio(1); _Pragma("unroll") for (int m = 0; m < 4; ++m) _Pragma("unroll") for (int n = 0; n < 2; ++n) _Pragma("unroll") for (int k = 0; k < 2; ++k) \
        acc[ai][bj][m][n] = __builtin_amdgcn_mfma_f32_16x16x32_bf16(Bt[n][k], At[m][k], acc[ai][bj][m][n], 0, 0, 0); __builtin_amdgcn_s_setprio(0); } while (0)
#define PG8_WAIT_V(n) asm volatile("s_waitcnt vmcnt(" #n ")" ::: "memory")
#define PG8_WAIT_L(n) asm volatile("s_waitcnt lgkmcnt(" #n ")" ::: "memory")
#define PG8_BAR __builtin_amdgcn_s_barrier()
#define PG8_SCHED __builtin_amdgcn_sched_barrier(0)
    Unit cur, nxt; int ui = 0;
    if (!S.next(0, cur)) return;
    f32x4 acc[2][2][4][2];
#pragma unroll
    for (int a = 0; a < 2; ++a)
#pragma unroll
        for (int b = 0; b < 2; ++b)
#pragma unroll
            for (int m = 0; m < 4; ++m)
#pragma unroll
                for (int n = 0; n < 2; ++n) acc[a][b][m][n] = (f32x4){0.f, 0.f, 0.f, 0.f};
    bf16x8 At[4][2], B0[2][2], B1[2][2];
    const char* cA = cur.A; const char* cB = cur.B;
    PG8_STAGE(PG8_SB(0, 0), cB, voffB); PG8_STAGE(PG8_SB(0, 1), cB + hstepB, voffB); PG8_STAGE(PG8_SA(0, 0), cA, voffA); PG8_STAGE(PG8_SA(0, 1), cA + hstepA, voffA);
    if (wr == 1) PG8_BAR;
    PG8_WAIT_V(2); PG8_BAR;
    PG8_STAGE(PG8_SB(1, 0), cB + kstep, voffB); PG8_STAGE(PG8_SA(1, 0), cA + kstep, voffA); PG8_STAGE(PG8_SB(1, 1), cB + hstepB + kstep, voffB);
    PG8_WAIT_V(6); PG8_BAR;
    for (;;) {
        const bool has_next = S.next(ui + 1, nxt);
        const char* nA = has_next ? nxt.A : cA; const char* nB = has_next ? nxt.B : cB;
        for (int t = 0; t < nt; t += 2) {
            const bool last = (t == nt - 2);
            const char* a1 = cA + (size_t)(t + 1) * kstep;
            const char* a2 = last ? nA : cA + (size_t)(t + 2) * kstep; const char* b2 = last ? nB : cB + (size_t)(t + 2) * kstep;
            const char* a3 = a2 + kstep; const char* b3 = b2 + kstep;
            PG8_LDB(B0, 0, 0); PG8_LDB(B1, 0, 1); PG8_SCHED; PG8_LDA(At, 0, 0); PG8_STAGE(PG8_SA(1, 1), a1 + hstepA, voffA);
            PG8_WAIT_V(8); PG8_WAIT_L(0); PG8_BAR; PG8_MMA(0, 0, At, B0); PG8_MMA(0, 1, At, B1); PG8_BAR; PG8_SCHED;
            PG8_LDA(At, 0, 1); PG8_STAGE(PG8_SB(0, 0), b2, voffB); PG8_STAGE(PG8_SB(0, 1), b2 + hstepB, voffB); PG8_STAGE(PG8_SA(0, 0), a2, voffA);
            PG8_WAIT_V(8); PG8_WAIT_L(0); PG8_BAR; PG8_MMA(1, 0, At, B0); PG8_MMA(1, 1, At, B1); PG8_BAR; PG8_SCHED;
            PG8_LDB(B0, 1, 0); PG8_LDB(B1, 1, 1); PG8_SCHED; PG8_LDA(At, 1, 0); PG8_STAGE(PG8_SA(0, 1), a2 + hstepA, voffA);
            PG8_WAIT_V(8); PG8_WAIT_L(0); PG8_BAR; PG8_MMA(0, 0, At, B0); PG8_MMA(0, 1, At, B1); PG8_BAR; PG8_SCHED;
            PG8_LDA(At, 1, 1); PG8_STAGE(PG8_SB(1, 0), b3, voffB); PG8_STAGE(PG8_SB(1, 1), b3 + hstepB, voffB); PG8_STAGE(PG8_SA(1, 0), a3, voffA);
            PG8_WAIT_V(8); PG8_WAIT_L(0); PG8_BAR; PG8_MMA(1, 0, At, B0); PG8_MMA(1, 1, At, B1); PG8_BAR; PG8_SCHED;
        }
        if constexpr (ALIGN_EPI) { if (wr == 0) PG8_BAR; }
        if constexpr (!Epi::AFTER_DRAIN) { E(acc, cur, wr, wc, fr, fq); }
        if (!has_next) break;
#pragma unroll
        for (int a = 0; a < 2; ++a)
#pragma unroll
            for (int b = 0; b < 2; ++b)
#pragma unroll
                for (int m = 0; m < 4; ++m)
#pragma unroll
                    for (int n = 0; n < 2; ++n) acc[a][b][m][n] = (f32x4){0.f, 0.f, 0.f, 0.f};
        cur = nxt; cA = nA; cB = nB; ++ui;
        if constexpr (ALIGN_EPI) { if (wr == 1) PG8_BAR; }
    }
    PG8_WAIT_V(0);
    if constexpr (!ALIGN_EPI) { if (wr == 0) PG8_BAR; }
    PG8_BAR;
    if constexpr (Epi::AFTER_DRAIN) { E.fused(acc, cur, wr, wc, fr, fq, lds, wid, lane); }
#undef PG8_SA
#undef PG8_SB
#undef PG8_STAGE
#undef PG8_LDA
#undef PG8_LDB
#undef PG8_MMA
#undef PG8_WAIT_V
#undef PG8_WAIT_L
#undef PG8_BAR
#undef PG8_SCHED
}

struct GridOrder {
    const char* A; const char* B; size_t astep, bstep; int nM, nN, nwg, G, c;
    __device__ void init(const void* A_, const void* B_, int lda, int ldb, int M, int N, int G_, int c_) { A = (const char*)A_; B = (const char*)B_; astep = (size_t)BM * lda * 2; bstep = (size_t)BM * ldb * 2; nM = M / BM; nN = N / BM; nwg = nM * nN; G = G_; c = c_; }
    __device__ bool next(int i, Unit& u) const {
        const long L = (long)i * G + c; if (L >= nwg) return false;
        int wgid = (int)L; { const int q = nwg / 8, r = nwg % 8, xcd = wgid % 8, off = wgid / 8; wgid = (xcd < r ? xcd * (q + 1) : r * (q + 1) + (xcd - r) * q) + off; }
        const int nig = 8 * nN, gid = wgid / nig, fm = gid * 8, gsz = (nM - fm) < 8 ? (nM - fm) : 8;
        u.pm = fm + ((wgid % nig) % gsz); u.pn = (wgid % nig) / gsz; u.A = A + (size_t)u.pm * astep; u.B = B + (size_t)u.pn * bstep; return true;
    }
};
struct OneUnit {
    Unit u; int valid;
    __device__ bool next(int i, Unit& o) const { if (i == 0 && valid) { o = u; return true; } return false; }
};
}

struct EpiP1 {
    static constexpr bool PERM = true, AFTER_DRAIN = false;
    const float* rstd; bf16_t* uext; bf16_t* hconv;
    __device__ __forceinline__ void operator()(const f32x4 (&acc)[2][2][4][2], const pg8::Unit& u, int wr, int wc, int fr, int fq) const {
        asm volatile("" : "+v"(fr), "+v"(fq));
        const int row0 = u.pm * 256 + wr * 64 + fr;
        if (u.pn < 2) {
#pragma unroll
            for (int ai = 0; ai < 2; ++ai)
#pragma unroll
                for (int m = 0; m < 4; ++m) { const int row = row0 + ai * 128 + m * 16; const float rs = rstd[row]; const int ch = row >> 4, j = row & 15;
#pragma unroll
                    for (int bj = 0; bj < 2; ++bj) { const int g = 16 * u.pn + 8 * bj + 2 * wc + (fq >> 1);
                        const f32x4 v0 = acc[ai][bj][m][0] * rs, v1 = acc[ai][bj][m][1] * rs;
                        u32x4 w; w.x = cvt_pk_bf16(v0[0], v0[1]); w.y = cvt_pk_bf16(v0[2], v0[3]); w.z = cvt_pk_bf16(v1[0], v1[1]); w.w = cvt_pk_bf16(v1[2], v1[3]);
                        *(u32x4*)(uext + ((size_t)(g * NCH + ch)) * KX + j * 16 + 8 * (fq & 1)) = w; } }
        } else {
            const int q = u.pn - 2;
#pragma unroll
            for (int ai = 0; ai < 2; ++ai)
#pragma unroll
                for (int m = 0; m < 4; ++m) { const int row = row0 + ai * 128 + m * 16; const float rs = rstd[row];
                    float h[8];
#pragma unroll
                    for (int n = 0; n < 2; ++n)
#pragma unroll
                        for (int i = 0; i < 4; ++i) { const float v = acc[ai][0][m][n][i] * rs, gt = acc[ai][1][m][n][i] * rs; h[n * 4 + i] = v * sigmoidf_(gt); }
                    u32x4 w; w.x = cvt_pk_bf16(h[0], h[1]); w.y = cvt_pk_bf16(h[2], h[3]); w.z = cvt_pk_bf16(h[4], h[5]); w.w = cvt_pk_bf16(h[6], h[7]);
                    *(u32x4*)(hconv + (size_t)row * 512 + 128 * q + 32 * wc + 8 * fq) = w; }
        }
    }
};

struct EpiScan {
    static constexpr bool PERM = false, AFTER_DRAIN = true;
    const float* lpow; bf16_t* uext; int g, pn;
    __device__ __forceinline__ void fused(const f32x4 (&acc)[2][2][4][2], const pg8::Unit&, int wr, int wc, int fr, int fq, LAS unsigned char* lds, int wid, int lane) const {
        asm volatile("" : "+v"(fr), "+v"(fq), "+v"(lane));
        LAS float* SL = (LAS float*)lds;
        LAS f32x2* XE = (LAS f32x2*)(lds + 131072);
#pragma unroll
        for (int bj = 0; bj < 2; ++bj)
#pragma unroll
            for (int m = 0; m < 4; ++m)
#pragma unroll
                for (int n = 0; n < 2; ++n)
#pragma unroll
                    for (int i = 0; i < 4; ++i) { const int r = 64 * wr + 16 * m + fr, c = 128 * bj + 32 * wc + 16 * n + 4 * fq + i; SL[c * 128 + r] = acc[0][bj][m][n][i]; }
        LDS_WAIT(); __builtin_amdgcn_s_barrier(); asm volatile("" ::: "memory");
        const int p = lane, seg = wid & 3, bb = wid >> 2, c0 = 128 * bb + 32 * seg;
        const f32x4 lp = *(const f32x4*)(lpow + (size_t)(g * 64 + p) * 4);
        float er = 0.f, ei = 0.f;
        for (int i = 0; i < 32; ++i) { const float sr = SL[(c0 + i) * 128 + p], si = SL[(c0 + i) * 128 + 64 + p];
            const float nr = lp.x * er - lp.y * ei + sr, ni = lp.x * ei + lp.y * er + si; er = nr; ei = ni; }
        XE[(bb * 4 + seg) * 64 + p] = (f32x2){er, ei};
        LDS_WAIT(); __builtin_amdgcn_s_barrier(); asm volatile("" ::: "memory");
        float sr_ = 0.f, si_ = 0.f;
        for (int s = 0; s < 3; ++s) if (s < seg) { const f32x2 e = XE[(bb * 4 + s) * 64 + p]; const float nr = lp.z * sr_ - lp.w * si_ + e.x, ni = lp.z * si_ + lp.w * sr_ + e.y; sr_ = nr; si_ = ni; }
        for (int i = 0; i < 32; ++i) { const int chunk = 256 * pn + c0 + i; bf16_t* dst = uext + ((size_t)(g * NCH + chunk)) * KX;
            dst[256 + p] = (bf16_t)f2bf(sr_); dst[320 + p] = (bf16_t)f2bf(si_);
            const float lr = SL[(c0 + i) * 128 + p], li = SL[(c0 + i) * 128 + 64 + p];
            const float nr = lp.x * sr_ - lp.y * si_ + lr, ni = lp.x * si_ + lp.y * sr_ + li; sr_ = nr; si_ = ni; }
    }
};

typedef short s16x4 __attribute__((ext_vector_type(4)));
struct EpiGlu {
    static constexpr bool PERM = false, AFTER_DRAIN = false;
    const float* glu_w; const float* glu_b; bf16_t* ycat; int g, pn;
    __device__ __forceinline__ void operator()(const f32x4 (&acc)[2][2][4][2], const pg8::Unit&, int wr, int wc, int fr, int fq) const {
        asm volatile("" : "+v"(fr), "+v"(fq));
        const float* gw = glu_w + g * 256;
        s16x4 wa;
        { const unsigned p0 = cvt_pk_bf16_c(gw[(4 * fq + 0) * 16 + fr], gw[(4 * fq + 1) * 16 + fr]), p1 = cvt_pk_bf16_c(gw[(4 * fq + 2) * 16 + fr], gw[(4 * fq + 3) * 16 + fr]);
          wa[0] = (short)(p0 & 0xFFFFu); wa[1] = (short)(p0 >> 16); wa[2] = (short)(p1 & 0xFFFFu); wa[3] = (short)(p1 >> 16); }
        const f32x4 b4 = *(const f32x4*)(glu_b + g * 16 + 4 * fq);
#pragma unroll
        for (int ai = 0; ai < 2; ++ai)
#pragma unroll
            for (int m = 0; m < 4; ++m) { const int chunk = 256 * pn + 128 * ai + 64 * wr + 16 * m + fr;
#pragma unroll
                for (int bj = 0; bj < 2; ++bj)
#pragma unroll
                    for (int n = 0; n < 2; ++n) {
                        const f32x4 a = acc[ai][bj][m][n];
                        const f32x2 y01 = gelu_pk((f32x2){a[0], a[1]}), y23 = gelu_pk((f32x2){a[2], a[3]});
                        const unsigned q0 = cvt_pk_bf16_c(y01.x, y01.y), q1 = cvt_pk_bf16_c(y23.x, y23.y);
                        s16x4 yb; yb[0] = (short)(q0 & 0xFFFFu); yb[1] = (short)(q0 >> 16); yb[2] = (short)(q1 & 0xFFFFu); yb[3] = (short)(q1 >> 16);
                        const f32x4 gt = __builtin_amdgcn_mfma_f32_16x16x16bf16_1k(wa, yb, b4, 0, 0, 0);
                        const float o0 = y01.x * sigmoidf_(gt[0]), o1 = y01.y * sigmoidf_(gt[1]), o2 = y23.x * sigmoidf_(gt[2]), o3 = y23.y * sigmoidf_(gt[3]);
                        const int j = 8 * bj + 2 * wc + n, t = chunk * 16 + j;
                        u32x2 w; w.x = cvt_pk_bf16(o0, o1); w.y = cvt_pk_bf16(o2, o3);
                        *(u32x2*)(ycat + (size_t)t * DM + g * 16 + 4 * fq) = w;
                    } }
    }
};

struct EpiRes {
    static constexpr bool PERM = true, AFTER_DRAIN = false;
    const float* x; float* x1; bf16_t* xb1; float* ssq;
    __device__ __forceinline__ void operator()(const f32x4 (&acc)[2][2][4][2], const pg8::Unit& u, int wr, int wc, int fr, int fq) const {
        asm volatile("" : "+v"(fr), "+v"(fq));
        const int row0 = u.pm * 256 + wr * 64 + fr, col0 = u.pn * 256 + wc * 32 + 8 * fq;
#pragma unroll
        for (int ai = 0; ai < 2; ++ai)
#pragma unroll
            for (int m = 0; m < 4; ++m) { const int row = row0 + ai * 128 + m * 16; float s = 0.f;
#pragma unroll
                for (int bj = 0; bj < 2; ++bj) { const size_t off = (size_t)row * DM + col0 + bj * 128;
                    const u32x4 xq = *(const u32x4*)(xb1 + off);
                    const f32x4 o0 = (f32x4){bf2f(xq.x & 0xFFFFu), bf2f(xq.x >> 16), bf2f(xq.y & 0xFFFFu), bf2f(xq.y >> 16)} + acc[ai][bj][m][0];
                    const f32x4 o1 = (f32x4){bf2f(xq.z & 0xFFFFu), bf2f(xq.z >> 16), bf2f(xq.w & 0xFFFFu), bf2f(xq.w >> 16)} + acc[ai][bj][m][1];
                    s += ((o0[0] * o0[0] + o0[1] * o0[1]) + (o0[2] * o0[2] + o0[3] * o0[3])) + ((o1[0] * o1[0] + o1[1] * o1[1]) + (o1[2] * o1[2] + o1[3] * o1[3]));
                    u32x4 w; w.x = cvt_pk_bf16(o0[0], o0[1]); w.y = cvt_pk_bf16(o0[2], o0[3]); w.z = cvt_pk_bf16(o1[0], o1[1]); w.w = cvt_pk_bf16(o1[2], o1[3]); *(u32x4*)(xb1 + off) = w; }
                s += __shfl_xor(s, 16); s += __shfl_xor(s, 32);
                if (fq == 0) ssq[(size_t)row * 16 + u.pn * 4 + wc] = s; }
    }
};

struct EpiWqk {
    static constexpr bool PERM = false, AFTER_DRAIN = false;
    bf16_t* wqk;
    __device__ __forceinline__ void operator()(const f32x4 (&acc)[2][2][4][2], const pg8::Unit& u, int wr, int wc, int fr, int fq) const {
        asm volatile("" : "+v"(fr), "+v"(fq));
#pragma unroll
        for (int ai = 0; ai < 2; ++ai)
#pragma unroll
            for (int m = 0; m < 4; ++m) { const int row = u.pm * 256 + ai * 128 + wr * 64 + m * 16 + fr;
#pragma unroll
                for (int bj = 0; bj < 2; ++bj)
#pragma unroll
                    for (int n = 0; n < 2; ++n) { const f32x4 v = acc[ai][bj][m][n]; u32x2 w; w.x = cvt_pk_bf16(v[0], v[1]); w.y = cvt_pk_bf16(v[2], v[3]);
                        *(u32x2*)(wqk + (size_t)row * DM + u.pn * 256 + bj * 128 + wc * 32 + n * 16 + 4 * fq) = w; } }
    }
};
__device__ __forceinline__ unsigned mono_key(float x) { const unsigned u = __builtin_bit_cast(unsigned, x); return u ^ ((unsigned)((int)u >> 31) | 0x80000000u); }
#define CE_DESC(a, b) do { const unsigned _cmx = (a) > (b) ? (a) : (b); (b) = (a) > (b) ? (b) : (a); (a) = _cmx; } while (0)
#define CE_ASC(a, b) do { const unsigned _cmn = (a) > (b) ? (b) : (a); (b) = (a) > (b) ? (a) : (b); (a) = _cmn; } while (0)
#define SORT16_DESC(X) do { CE_DESC(X[0], X[1]); CE_DESC(X[2], X[3]); CE_DESC(X[0], X[2]); CE_DESC(X[1], X[3]); CE_DESC(X[1], X[2]); CE_DESC(X[4], X[5]); CE_DESC(X[6], X[7]); CE_DESC(X[4], X[6]); CE_DESC(X[5], X[7]); CE_DESC(X[5], X[6]); CE_DESC(X[0], X[4]); CE_DESC(X[2], X[6]); CE_DESC(X[2], X[4]); CE_DESC(X[1], X[5]); CE_DESC(X[3], X[7]); CE_DESC(X[3], X[5]); CE_DESC(X[1], X[2]); CE_DESC(X[3], X[4]); CE_DESC(X[5], X[6]); CE_DESC(X[8], X[9]); CE_DESC(X[10], X[11]); CE_DESC(X[8], X[10]); CE_DESC(X[9], X[11]); CE_DESC(X[9], X[10]); CE_DESC(X[12], X[13]); CE_DESC(X[14], X[15]); CE_DESC(X[12], X[14]); CE_DESC(X[13], X[15]); CE_DESC(X[13], X[14]); CE_DESC(X[8], X[12]); CE_DESC(X[10], X[14]); CE_DESC(X[10], X[12]); CE_DESC(X[9], X[13]); CE_DESC(X[11], X[15]); CE_DESC(X[11], X[13]); CE_DESC(X[9], X[10]); CE_DESC(X[11], X[12]); CE_DESC(X[13], X[14]); CE_DESC(X[0], X[8]); CE_DESC(X[4], X[12]); CE_DESC(X[4], X[8]); CE_DESC(X[2], X[10]); CE_DESC(X[6], X[14]); CE_DESC(X[6], X[10]); CE_DESC(X[2], X[4]); CE_DESC(X[6], X[8]); CE_DESC(X[10], X[12]); CE_DESC(X[1], X[9]); CE_DESC(X[5], X[13]); CE_DESC(X[5], X[9]); CE_DESC(X[3], X[11]); CE_DESC(X[7], X[15]); CE_DESC(X[7], X[11]); CE_DESC(X[3], X[5]); CE_DESC(X[7], X[9]); CE_DESC(X[11], X[13]); CE_DESC(X[1], X[2]); CE_DESC(X[3], X[4]); CE_DESC(X[5], X[6]); CE_DESC(X[7], X[8]); CE_DESC(X[9], X[10]); CE_DESC(X[11], X[12]); CE_DESC(X[13], X[14]); } while (0)
#define TOP16_MERGE(L, P) do { _Pragma("unroll") for (int _i = 0; _i < 16; ++_i) L[_i] = L[_i] > P[15 - _i] ? L[_i] : P[15 - _i]; \
    _Pragma("unroll") for (int _j = 8; _j > 0; _j >>= 1) _Pragma("unroll") for (int _i = 0; _i < 16; ++_i) { const int _l = _i ^ _j; if (_l > _i) CE_DESC(L[_i], L[_l]); } } while (0)
struct EpiTopk {
    static constexpr bool PERM = false, AFTER_DRAIN = true;
    const LAS float* rsv; int* sele; float* selg;
    __device__ __forceinline__ void fused(const f32x4 (&acc)[2][2][4][2], const pg8::Unit& u, int wr, int wc, int fr, int fq, LAS unsigned char* lds, int wid, int lane) const {
        asm volatile("" : "+v"(fr), "+v"(fq), "+v"(lane));
        constexpr int SCP = 260;
        LAS float* SC = (LAS float*)lds;
        LAS unsigned* XL = (LAS unsigned*)(lds + 128 * SCP * 4);
        LAS float* LST = (LAS float*)lds;
        const int tid = wid * 64 + lane;
#pragma unroll
        for (int ai = 0; ai < 2; ++ai) {
#pragma unroll
            for (int m = 0; m < 4; ++m) {
                const int rr = 64 * wr + 16 * m + fr;
                const float rs = rsv[ai * 128 + rr];
#pragma unroll
                for (int bj = 0; bj < 2; ++bj)
#pragma unroll
                    for (int n = 0; n < 2; ++n) { const int c = 128 * bj + 32 * wc + 16 * n + 4 * fq; *(LAS f32x4*)(SC + rr * SCP + c) = acc[ai][bj][m][n] * rs; }
            }
            LDS_WAIT(); __builtin_amdgcn_s_barrier(); asm volatile("" ::: "memory");
            const int rr = tid & 127, part = tid >> 7, half = part >> 1, sub = part & 1;
            unsigned L[16];
            { const LAS f32x4* src = (const LAS f32x4*)(SC + rr * SCP + 128 * half + 64 * sub);
#define LOADKEYS(X, g) do { _Pragma("unroll") for (int i4 = 0; i4 < 4; ++i4) { const f32x4 sv = src[4 * (g) + i4]; _Pragma("unroll") for (int i1 = 0; i1 < 4; ++i1) \
                  X[4 * i4 + i1] = (mono_key(sv[i1]) & 0xFFFFFF80u) | (unsigned)(127 - (64 * sub + 16 * (g) + 4 * i4 + i1)); } } while (0)
              LOADKEYS(L, 0); SORT16_DESC(L);
#pragma unroll 1
              for (int g = 1; g < 4; ++g) {
                  unsigned Gp[16];
                  LOADKEYS(Gp, g);
                  SORT16_DESC(Gp); TOP16_MERGE(L, Gp);
              }
#undef LOADKEYS
            }
            if (sub == 1) {
#pragma unroll
                for (int i = 0; i < 16; ++i) XL[(rr * 2 + half) * 16 + i] = L[i]; }
            LDS_WAIT(); __builtin_amdgcn_s_barrier(); asm volatile("" ::: "memory");
            float v[16]; int id[16];
            if (sub == 0) {
                unsigned Pp[16];
#pragma unroll
                for (int i = 0; i < 16; ++i) Pp[i] = XL[(rr * 2 + half) * 16 + i];
                TOP16_MERGE(L, Pp);
#pragma unroll
                for (int i = 0; i < 16; ++i) { id[i] = 127 - (int)(L[i] & 127u); v[i] = SC[rr * SCP + 128 * half + id[i]]; }
            }
            LDS_WAIT(); __builtin_amdgcn_s_barrier(); asm volatile("" ::: "memory");
            if (sub == 0) {
#pragma unroll
                for (int i = 0; i < 16; ++i) { LST[(rr * 2 + half) * 32 + i] = v[i]; LST[(rr * 2 + half) * 32 + 16 + i] = __builtin_bit_cast(float, id[i]); } }
            LDS_WAIT(); __builtin_amdgcn_s_barrier(); asm volatile("" ::: "memory");
            if (tid < 128) {
                const int r2 = tid;
                float v1[16], v2[16];
#pragma unroll
                for (int i = 0; i < 16; ++i) { v1[i] = LST[(r2 * 2 + 0) * 32 + i]; v2[i] = LST[(r2 * 2 + 1) * 32 + i]; }
#define CKEY(i, j) ((mono_key(v1[i] + v2[j]) & 0xFFFFFF00u) | (unsigned)(255 - ((i) * 16 + (j))))
                unsigned C[16], P[16];
#pragma unroll
                for (int j = 0; j < 16; ++j) C[j] = CKEY(0, j);
#pragma unroll
                for (int j = 0; j < 16; ++j) P[j] = j < 8 ? CKEY(1, j) : 0u;
                TOP16_MERGE(C, P);
                P[0] = CKEY(2, 0); P[1] = CKEY(2, 1); P[2] = CKEY(2, 2); P[3] = CKEY(2, 3); P[4] = CKEY(2, 4); P[5] = CKEY(3, 0); P[6] = CKEY(3, 1); P[7] = CKEY(3, 2); P[8] = CKEY(3, 3);
                P[9] = CKEY(4, 0); P[10] = CKEY(4, 1); P[11] = CKEY(4, 2); P[12] = CKEY(5, 0); P[13] = CKEY(5, 1); P[14] = CKEY(6, 0); P[15] = CKEY(6, 1);
                SORT16_DESC(P); TOP16_MERGE(C, P);
                P[0] = CKEY(7, 0); P[1] = CKEY(7, 1);
#pragma unroll
                for (int i = 8; i < 16; ++i) P[i - 6] = CKEY(i, 0);
#pragma unroll
                for (int i = 10; i < 16; ++i) P[i] = 0u;
                SORT16_DESC(P); TOP16_MERGE(C, P);
#undef CKEY
                float sc[16]; int eid[16]; float mx = -3.0e38f;
#pragma unroll
                for (int k = 0; k < 16; ++k) { const int ci = 255 - (int)(C[k] & 255u), i = ci >> 4, j = ci & 15;
                    sc[k] = LST[(r2 * 2 + 0) * 32 + i] + LST[(r2 * 2 + 1) * 32 + j];
                    const int e1 = __builtin_bit_cast(int, LST[(r2 * 2 + 0) * 32 + 16 + i]), e2 = __builtin_bit_cast(int, LST[(r2 * 2 + 1) * 32 + 16 + j]);
                    eid[k] = e1 * 128 + e2; mx = fmaxf(mx, sc[k]); }
                float sum = 0.f;
#pragma unroll
                for (int k = 0; k < 16; ++k) { sc[k] = __expf(sc[k] - mx); sum += sc[k]; }
                const float inv = 1.0f / sum;
                LAS int* pe = (LAS int*)XL + r2 * 16; LAS float* pg = (LAS float*)XL + 2048 + r2 * 16;
#pragma unroll
                for (int k = 0; k < 16; ++k) { pe[k] = eid[k]; pg[k] = sc[k] * inv; }
            }
            LDS_WAIT(); __builtin_amdgcn_s_barrier(); asm volatile("" ::: "memory");
            {
                const int idx = 4 * tid, t = u.pm * 256 + ai * 128 + (idx >> 4);
                *(i32x4*)(sele + (size_t)t * 128 + u.pn * 16 + (idx & 15)) = *(const LAS i32x4*)((const LAS int*)XL + idx);
                *(f32x4*)(selg + (size_t)t * 128 + u.pn * 16 + (idx & 15)) = *(const LAS f32x4*)((const LAS float*)XL + 2048 + idx);
            }
            LDS_WAIT(); asm volatile("" ::: "memory");
        }
    }
};

template <int TT>
__device__ __forceinline__ void conv_tiles(LAS unsigned char* lds, const float* PAR, const bf16_t* HCONV, bf16_t* YCAT, int first, int last, int stride, const int wave0) {
    int tid = (wave0 << 6) | lane_id_(); asm volatile("" : "+v"(tid));
    const int lane = tid & 63, wave = __builtin_amdgcn_readfirstlane(tid >> 6);
    LAS unsigned char* HC = lds;
    LAS f32x2* RED = (LAS f32x2*)(lds + 98304);
    const int c = tid;
    float w[31];
#pragma unroll
    for (int k = 0; k < 31; ++k) w[k] = PAR[PO_CW + k * 512 + c];
    const float cb = PAR[PO_CB + c], lng = PAR[PO_LNG + c], lnb = PAR[PO_LNB + c];
    const bool b0 = (lane & 1) != 0, b1 = (lane & 2) != 0, b2 = (lane & 4) != 0, b3 = (lane & 8) != 0;
    for (int tt = first; tt < last; tt += stride) {
        const int t0 = tt * TT, pos0 = t0 & (SEQ - 1);
        {
            constexpr int NST = ((TT + 30) * 64 + NTHR - 1) / NTHR;
            u32x4 val[NST];
#pragma unroll
            for (int q = 0; q < NST; ++q) { const int idx = tid + q * NTHR, r = idx >> 6, cc = idx & 63; val[q] = (u32x4){0u, 0u, 0u, 0u};
                if (idx < (TT + 30) * 64 && pos0 - 30 + r >= 0) val[q] = *(const u32x4*)(HCONV + (size_t)(t0 - 30 + r) * 512 + cc * 8); }
#pragma unroll
            for (int q = 0; q < NST; ++q) { const int idx = tid + q * NTHR, r = idx >> 6, cc = idx & 63; if (idx < (TT + 30) * 64) *(LAS u32x4*)(HC + r * 1024 + cc * 16) = val[q]; }
        }
        LDS_WAIT(); __syncthreads();
        for (int tb = 0; tb < TT / 16; ++tb) {
            float in[46];
#pragma unroll
            for (int i = 0; i < 46; ++i) in[i] = bf2f(*(const LAS unsigned short*)(HC + (16 * tb + i) * 1024 + c * 2));
            float o[16];
            {
                f32x2 ine[23], ino[23];
#pragma unroll
                for (int i = 0; i < 23; ++i) { ine[i] = (f32x2){in[2 * i], in[2 * i + 1]}; ino[i] = (f32x2){in[2 * i + 1], (2 * i + 2 < 46) ? in[2 * i + 2] : 0.f}; }
                f32x2 o2[8];
#pragma unroll
                for (int t2 = 0; t2 < 8; ++t2) o2[t2] = (f32x2){cb, cb};
#pragma unroll
                for (int k = 0; k < 31; ++k) { const f32x2 wk = (f32x2){w[k], w[k]};
#pragma unroll
                    for (int t2 = 0; t2 < 8; ++t2) o2[t2] = __builtin_elementwise_fma(wk, (k & 1) ? ino[t2 + (k >> 1)] : ine[t2 + (k >> 1)], o2[t2]); }
#pragma unroll
                for (int t2 = 0; t2 < 8; ++t2) { o[2 * t2] = o2[t2].x; o[2 * t2 + 1] = o2[t2].y; }
            }
            {
                float a1[8], a2[8];
#define XCH1(v) dpp_f<0xB1>(v)
#define XCH2(v) dpp_f<0x4E>(v)
#define XCH4(v) dpp_f<0x141>(dpp_f<0x1B>(v))
#define XCH8(v) dpp_f<0x128>(v)
#pragma unroll
                for (int j = 0; j < 8; ++j) { const float e = o[2 * j], d = o[2 * j + 1], e2 = e * e, d2 = d * d;
                    const float k1 = b0 ? d : e, s1 = b0 ? e : d, k2 = b0 ? d2 : e2, s2 = b0 ? e2 : d2; a1[j] = k1 + XCH1(s1); a2[j] = k2 + XCH1(s2); }
#pragma unroll
                for (int j = 0; j < 4; ++j) { const float k1 = b1 ? a1[2 * j + 1] : a1[2 * j], s1 = b1 ? a1[2 * j] : a1[2 * j + 1], k2 = b1 ? a2[2 * j + 1] : a2[2 * j], s2 = b1 ? a2[2 * j] : a2[2 * j + 1];
                    a1[j] = k1 + XCH2(s1); a2[j] = k2 + XCH2(s2); }
#pragma unroll
                for (int j = 0; j < 2; ++j) { const float k1 = b2 ? a1[2 * j + 1] : a1[2 * j], s1 = b2 ? a1[2 * j] : a1[2 * j + 1], k2 = b2 ? a2[2 * j + 1] : a2[2 * j], s2 = b2 ? a2[2 * j] : a2[2 * j + 1];
                    a1[j] = k1 + XCH4(s1); a2[j] = k2 + XCH4(s2); }
                { const float k1 = b3 ? a1[1] : a1[0], s1 = b3 ? a1[0] : a1[1], k2 = b3 ? a2[1] : a2[0], s2 = b3 ? a2[0] : a2[1]; a1[0] = k1 + XCH8(s1); a2[0] = k2 + XCH8(s2); }
                float r1 = a1[0], r2 = a2[0];
                r1 += __builtin_bit_cast(float, __builtin_amdgcn_ds_swizzle(__builtin_bit_cast(int, r1), 0x401F)); r2 += __builtin_bit_cast(float, __builtin_amdgcn_ds_swizzle(__builtin_bit_cast(int, r2), 0x401F));
                { const u32x2 p1 = __builtin_amdgcn_permlane32_swap(__builtin_bit_cast(unsigned, r1), __builtin_bit_cast(unsigned, r1), false, false), p2 = __builtin_amdgcn_permlane32_swap(__builtin_bit_cast(unsigned, r2), __builtin_bit_cast(unsigned, r2), false, false);
                  r1 += __builtin_bit_cast(float, lane < 32 ? p1.y : p1.x); r2 += __builtin_bit_cast(float, lane < 32 ? p2.y : p2.x); }
                if (lane < 16) RED[(tb * 16 + lane) * 8 + wave] = (f32x2){r1, r2};
#undef XCH1
#undef XCH2
#undef XCH4
#undef XCH8
            }
            LDS_WAIT(); __syncthreads();
            float mu_l, rs_l;
            { const LAS f32x4* rp = (const LAS f32x4*)(RED + (tb * 16 + (lane & 15)) * 8); const f32x4 q0 = rp[0], q1 = rp[1], q2 = rp[2], q3 = rp[3];
              const float s1 = ((q0[0] + q0[2]) + (q1[0] + q1[2])) + ((q2[0] + q2[2]) + (q3[0] + q3[2])), s2 = ((q0[1] + q0[3]) + (q1[1] + q1[3])) + ((q2[1] + q2[3]) + (q3[1] + q3[3]));
              mu_l = s1 * (1.0f / 512.0f); const float var = fmaxf(s2 * (1.0f / 512.0f) - mu_l * mu_l, 0.f); rs_l = rsqrtf(var + EPS); }
#pragma unroll
            for (int t = 0; t < 16; ++t) {
                const float mu = __builtin_bit_cast(float, __builtin_amdgcn_readlane(__builtin_bit_cast(int, mu_l), t)), rs = __builtin_bit_cast(float, __builtin_amdgcn_readlane(__builtin_bit_cast(int, rs_l), t));
                const float y = (o[t] - mu) * rs * lng + lnb, z = y * sigmoidf_(y);
                *(LAS unsigned short*)(HC + (16 * tb + t) * 1024 + c * 2) = (unsigned short)f2bf(z); }
        }
        LDS_WAIT(); __syncthreads();
        for (int idx = tid; idx < TT * 64; idx += NTHR) { const int r = idx >> 6, cc = idx & 63;
            *(u32x4*)(YCAT + (size_t)(t0 + r) * DM + 512 + cc * 8) = *(const LAS u32x4*)(HC + r * 1024 + cc * 16); }
        LDS_WAIT(); __syncthreads();
    }
}

#define XB_TMO      128
#define XB_XCNT(j)  (256  + 64 * (j))
#define XB_XSUB(j)  (1280 + 64 * (j))
#define XB_XGEN(j)  (2304 + 64 * (j))
#define XB_TOP      3328
#define XB_TOPGEN   3392
#define XCD_BAR_WORDS 3456
#define XB_SPIN_CAP (1u << 22)
__device__ __forceinline__ unsigned xb_ld(unsigned* p)              { return __hip_atomic_load(p, __ATOMIC_RELAXED, __HIP_MEMORY_SCOPE_AGENT); }
__device__ __forceinline__ unsigned xb_add(unsigned* p, unsigned v) { return __hip_atomic_fetch_add(p, v, __ATOMIC_RELAXED, __HIP_MEMORY_SCOPE_AGENT); }
__device__ __forceinline__ unsigned xb_xcc_id() { return (unsigned)__builtin_amdgcn_s_getreg((3 << 11) | 20) & 0xFu; }
#define XB_SPIN(cond, bar) do { unsigned _sp = 0; while (cond) { __builtin_amdgcn_s_sleep(1); \
    if ((++_sp & 255u) == 0u) { if (xb_ld(&(bar)[XB_TMO])) break; if (_sp > XB_SPIN_CAP) { atomicAdd(&(bar)[XB_TMO], 1u); break; } } } } while (0)
struct XcdBarrier { unsigned* bar; unsigned x; volatile LAS unsigned* st; };
__device__ __forceinline__ XcdBarrier xcd_barrier_post(unsigned* bar, volatile LAS unsigned* st, const bool t0) {
    XcdBarrier b; b.bar = bar; b.x = xb_xcc_id(); b.st = st;
    if (t0) (void)xb_add(&bar[XB_XCNT(b.x)], 1u);
    return b;
}
__device__ __forceinline__ void xcd_barrier_complete(unsigned* bar, unsigned x, unsigned& nloc, unsigned& nx) {
    const unsigned G = gridDim.x * gridDim.y * gridDim.z;
    unsigned sum, cnt, mine, sp = 0u;
    for (;;) {
        sum = 0u; cnt = 0u; mine = 0u;
#pragma unroll
        for (unsigned j = 0; j < 16; ++j) { const unsigned c = xb_ld(&bar[XB_XCNT(j)]); sum += c; cnt += (c > 0u) ? 1u : 0u; mine = (j == x) ? c : mine; }
        if (sum == G) break;
        __builtin_amdgcn_s_sleep(1);
        if ((++sp & 255u) == 0u) { if (xb_ld(&bar[XB_TMO])) break; if (sp > XB_SPIN_CAP) { atomicAdd(&bar[XB_TMO], 1u); break; } }
    }
    nloc = mine > 0u ? mine : 1u; nx = cnt > 0u ? cnt : 1u;
}
__device__ __forceinline__ void xcd_barrier(const XcdBarrier& b, const bool t0) {
    asm volatile("s_waitcnt vmcnt(0)" ::: "memory");
    __syncthreads();
    if (t0) {
        unsigned* bar = b.bar;
        __builtin_amdgcn_s_waitcnt(0);
        unsigned nloc = b.st[0], nx = b.st[1];
        if (nloc == 0u) { xcd_barrier_complete(bar, b.x, nloc, nx); b.st[0] = nloc; b.st[1] = nx; }
        const unsigned old = xb_add(&bar[XB_XSUB(b.x)], 1u);
        const unsigned gen = old / nloc;
        if (old + 1u == (gen + 1u) * nloc) {
            __builtin_amdgcn_fence(__ATOMIC_RELEASE, "agent");
            asm volatile("s_waitcnt vmcnt(0)" ::: "memory");
            const unsigned og = xb_add(&bar[XB_TOP], 1u);
            const unsigned tg = og / nx;
            if (og + 1u == (tg + 1u) * nx) xb_add(&bar[XB_TOPGEN], 1u);
            else XB_SPIN(xb_ld(&bar[XB_TOPGEN]) == tg, bar);
            __builtin_amdgcn_fence(__ATOMIC_ACQUIRE, "agent");
            xb_add(&bar[XB_XGEN(b.x)], 1u);
            asm volatile("s_waitcnt vmcnt(0)" ::: "memory");
        } else {
            XB_SPIN(xb_ld(&bar[XB_XGEN(b.x)]) == gen, bar);
            __builtin_amdgcn_fence(__ATOMIC_ACQUIRE, "agent");
            asm volatile("s_waitcnt vmcnt(0)" ::: "memory");
        }
    }
    __syncthreads();
}

struct Args { const float* in[25]; float* out; unsigned char* ws; int ph_lo, ph_hi; };
enum { I_X = 0, I_G1, I_WIN, I_LRE, I_LIM, I_LDT, I_BRE, I_BIM, I_CRE, I_CIM, I_D, I_GLUW, I_GLUB, I_CW, I_CB, I_LNG, I_LNB, I_WOUT, I_G2, I_WQ, I_K1, I_K2, I_U, I_V, I_FG };
constexpr int NPHASE = 9;

__device__ __forceinline__ void p0_transpose_item(const float* W, int ldw, int src0, const float* gk, bf16_t* WT, int KT, int dst0, int k0, LAS float* scr, int lane) {
    float wv_[32];
#pragma unroll
    for (int i = 0; i < 32; ++i) { const int kk = 2 * i + (lane >> 5); wv_[i] = W[(size_t)(k0 + kk) * ldw + src0 + (lane & 31)]; }
    const float gkv = gk ? gk[k0 + (lane & 63)] : 1.0f;
#pragma unroll
    for (int i = 0; i < 32; ++i) { const int kk = 2 * i + (lane >> 5); scr[kk * 33 + (lane & 31)] = wv_[i] * __shfl(gkv, kk); }
    LDS_WAIT(); asm volatile("" ::: "memory");
    const int c = lane & 7;
#pragma unroll
    for (int j = 0; j < 4; ++j) { const int n = (lane >> 3) + 8 * j; const LAS float* s = scr + (8 * c) * 33 + n;
        u32x4 o; o.x = cvt_pk_bf16(s[0 * 33], s[1 * 33]); o.y = cvt_pk_bf16(s[2 * 33], s[3 * 33]); o.z = cvt_pk_bf16(s[4 * 33], s[5 * 33]); o.w = cvt_pk_bf16(s[6 * 33], s[7 * 33]);
        *(u32x4*)(WT + (size_t)(dst0 + n) * KT + k0 + 8 * c) = o; }
    LDS_WAIT(); asm volatile("" ::: "memory");
}

typedef __attribute__((address_space(4))) const Args CArgs;
__global__ void __launch_bounds__(NTHR, 2) fwd_kernel(Args args_unused) {
    extern __shared__ __attribute__((aligned(16))) unsigned char lds_raw[];
    LAS unsigned char* lds = (LAS unsigned char*)lds_raw;
    CArgs* ap = (CArgs*)__builtin_amdgcn_kernarg_segment_ptr();
    struct { float* out; unsigned char* ws; int ph_lo, ph_hi; } args = {ap->out, ap->ws, ap->ph_lo, ap->ph_hi};
    const int wave0 = __builtin_amdgcn_readfirstlane((int)threadIdx.x >> 6);
#define T0_() (wave0 == 0 && lane_id_() == 0)
    const int G = gridDim.x, bx = blockIdx.x;
    const int vcu = (G % 8 == 0) ? (bx % 8) * (G / 8) + bx / 8 : bx;
    const int NGW = G * NWAVES;
#define PH_IDS() int tid = (wave0 << 6) | lane_id_(); asm volatile("" : "+v"(tid)); const int lane = tid & 63, wave = __builtin_amdgcn_readfirstlane(tid >> 6), gw = vcu * NWAVES + wave; (void)lane; (void)gw;
    unsigned char* ws = args.ws;
    bf16_t* WIN = (bf16_t*)(ws + WS_WIN); bf16_t* WOUT = (bf16_t*)(ws + WS_WOUT); bf16_t* WQB = (bf16_t*)(ws + WS_WQ); bf16_t* WQK = (bf16_t*)(ws + WS_WQK);
    bf16_t* KEXT = (bf16_t*)(ws + WS_KEXT); bf16_t* W1EXT = (bf16_t*)(ws + WS_W1EXT); bf16_t* KBLK = (bf16_t*)(ws + WS_KBLK);
    float* LPOW = (float*)(ws + WS_LPOW); float* RSTD1 = (float*)(ws + WS_RSTD1); float* SSQ2 = (float*)(ws + WS_SSQ2);
    int* SELE = (int*)(ws + WS_SELE); float* SELG = (float*)(ws + WS_SELG);
    unsigned char* UTAB = ws + WS_UTAB; unsigned char* VTAB = ws + WS_VTAB; int* EXPU = (int*)(ws + WS_EXPU); int* EXPV = (int*)(ws + WS_EXPV); bf16_t* XB = (bf16_t*)(ws + WS_XB);
    bf16_t* UEXT = (bf16_t*)(ws + WS_UEXT); bf16_t* HCONV = (bf16_t*)(ws + WS_HCONV); bf16_t* YCAT = (bf16_t*)(ws + WS_YCAT);
    float* X1 = args.out;
    float* PAR = (float*)(ws + WS_PAR);
    const int lo = args.ph_lo, hi = args.ph_hi;
    cooperative_groups::grid_group grid_ = cooperative_groups::this_grid();
    volatile LAS unsigned* MISC = (volatile LAS unsigned*)(lds + LDS_BYTES - 64);
    if (wave0 == 0 && lane_id_() < 16) MISC[lane_id_()] = 0u;
    __syncthreads();
    const XcdBarrier xbar = xcd_barrier_post((unsigned*)(ws + WS_CTL), MISC, T0_());
#define SEAM(k) do { if (lo <= (k) && (k) + 1 < hi) { if (lo < 0) grid_.sync(); else xcd_barrier(xbar, T0_()); } } while (0)
#ifndef PH_MASK
#define PH_MASK 0xFFFF
#endif
#define REP_MASK 0
#define IN(k) ((((PH_MASK) >> (k)) & 1) && lo <= (k) && (k) < hi)

    if (IN(0)) { for (int rep_ = 0; rep_ < (((REP_MASK) >> 0) & 1) + 1; ++rep_) { if (rep_) grid_.sync();
        PH_IDS();
        CArgs* pa = ap; asm volatile("" : "+s"(pa));
#define AIN(i) (pa->in[i])
        constexpr int I_IN = 16 * 48, I_OUT = 16 * 32;
        constexpr int NP5 = 4, NS5 = NG * NP5;
        if (bx < NS5) {
            const int g = bx / NP5, part = bx % NP5;
            LAS f32x2* LP = (LAS f32x2*)(lds + 70000);
            LAS float* BBr = (LAS float*)(lds + 70000 + 8704); LAS float* BBi = BBr + 1024;
            LAS f32x2* CC = (LAS f32x2*)(lds + 70000 + 16896);
            LAS float* TT = (LAS float*)(lds + 70000 + 25088);
            if (tid < 64) {
                const int p = tid;
                const double lr = (double)AIN(I_LRE)[g * 64 + p], li = (double)AIN(I_LIM)[g * 64 + p], dt = exp((double)AIN(I_LDT)[g]);
                const double m1 = exp(lr * dt), a1 = li * dt, lbr = m1 * cos(a1), lbi = m1 * sin(a1);
                const double nr = lbr - 1.0, ni = lbi, den = lr * lr + li * li, fr_ = (nr * lr + ni * li) / den, fi_ = (ni * lr - nr * li) / den;
                { double cr_ = 1.0, ci_ = 0.0;
                  for (int n = 0; n < 17; ++n) { LP[n * 64 + p] = (f32x2){(float)cr_, (float)ci_}; const double t_ = cr_ * lbr - ci_ * lbi; ci_ = cr_ * lbi + ci_ * lbr; cr_ = t_; } }
                for (int h = 0; h < 16; ++h) { const double br = (double)AIN(I_BRE)[(g * 64 + p) * 16 + h], bi = (double)AIN(I_BIM)[(g * 64 + p) * 16 + h];
                    BBr[p * 16 + h] = (float)(fr_ * br - fi_ * bi); BBi[p * 16 + h] = (float)(fr_ * bi + fi_ * br); }
                for (int h = 0; h < 16; ++h) CC[h * 64 + p] = (f32x2){AIN(I_CRE)[(g * 16 + h) * 64 + p], AIN(I_CIM)[(g * 16 + h) * 64 + p]};
            } else if (tid < 128 && part == 0) {
                const int p = tid - 64;
                const double lr = (double)AIN(I_LRE)[g * 64 + p], li = (double)AIN(I_LIM)[g * 64 + p], dt = exp((double)AIN(I_LDT)[g]);
                const double m16 = exp(lr * dt * 16.0), a16 = li * dt * 16.0, m512 = exp(lr * dt * 512.0), a512 = li * dt * 512.0;
                *(f32x4*)(LPOW + (size_t)(g * 64 + p) * 4) = (f32x4){(float)(m16 * cos(a16)), (float)(m16 * sin(a16)), (float)(m512 * cos(a512)), (float)(m512 * sin(a512))};
            }
            __syncthreads();
            {
                const int lag = tid >> 5, ho = (tid >> 1) & 15, h8 = (tid & 1) * 8;
                f32x4 s4[2] = {(f32x4){0.f, 0.f, 0.f, 0.f}, (f32x4){0.f, 0.f, 0.f, 0.f}};
#pragma unroll 2
                for (int p = 0; p < 64; ++p) { const f32x2 c = CC[ho * 64 + p], l = LP[lag * 64 + p];
                    const float cr = c.x * l.x - c.y * l.y, ci = c.x * l.y + c.y * l.x;
                    const LAS f32x4* br4 = (const LAS f32x4*)(BBr + p * 16 + h8); const LAS f32x4* bi4 = (const LAS f32x4*)(BBi + p * 16 + h8);
#pragma unroll
                    for (int e2 = 0; e2 < 2; ++e2) { const f32x4 re = br4[e2], im = bi4[e2]; s4[e2] = s4[e2] + re * cr - im * ci; } }
#pragma unroll
                for (int e = 0; e < 8; ++e) TT[(lag * 16 + ho) * 16 + h8 + e] = s4[e >> 2][e & 3];
            }
            __syncthreads();
            for (int o = part * NTHR + tid; o < 256 * 48; o += NP5 * NTHR) { const int r = o / 48, k8 = (o % 48) * 8, j = r >> 4, ho = r & 15; float v[8];
#pragma unroll
                for (int e = 0; e < 8; ++e) { const int kk = k8 + e; float x;
                    if (kk < 256) { const int ji = kk >> 4, hi_ = kk & 15; x = (ji <= j) ? TT[((j - ji) * 16 + ho) * 16 + hi_] : 0.f; if (ji == j && hi_ == ho) x += AIN(I_D)[g * 16 + ho]; }
                    else { const int p = (kk - 256) & 63; const f32x2 c = CC[ho * 64 + p], l = LP[(j + 1) * 64 + p]; x = (kk < 320) ? (c.x * l.x - c.y * l.y) : -(c.x * l.y + c.y * l.x); }
                    v[e] = x; }
                u32x4 w; w.x = cvt_pk_bf16(v[0], v[1]); w.y = cvt_pk_bf16(v[2], v[3]); w.z = cvt_pk_bf16(v[4], v[5]); w.w = cvt_pk_bf16(v[6], v[7]);
                *(u32x4*)(KEXT + ((size_t)g * 256 + r) * KX + k8) = w; }
            for (int o = part * NTHR + tid; o < 256 * 32; o += NP5 * NTHR) { const int r = o >> 5, k8 = (o & 31) * 8; float v[8];
#pragma unroll
                for (int e = 0; e < 8; ++e) { const int kk = k8 + e, j = kk >> 4, h = kk & 15; float x = 0.f;
                    if (r < 128) { const int p = r & 63; const f32x2 l = LP[(15 - j) * 64 + p]; const float bx_ = BBr[p * 16 + h], by_ = BBi[p * 16 + h]; x = (r < 64) ? (l.x * bx_ - l.y * by_) : (l.x * by_ + l.y * bx_); }
                    v[e] = x; }
                u32x4 w; w.x = cvt_pk_bf16(v[0], v[1]); w.y = cvt_pk_bf16(v[2], v[3]); w.z = cvt_pk_bf16(v[4], v[5]); w.w = cvt_pk_bf16(v[6], v[7]);
                *(u32x4*)(W1EXT + ((size_t)g * 256 + r) * 256 + k8) = w; }
            __syncthreads();
            {
                LAS float* scr5 = (LAS float*)(lds + wave * 8448);
                for (int r_ = bx * NWAVES + wave; r_ < I_OUT; r_ += NS5 * NWAVES) { const int kb = r_ / 32, nb = r_ % 32;
                    p0_transpose_item(AIN(I_WOUT), 1024, 32 * nb, nullptr, WOUT, DM, 32 * nb, 64 * kb, scr5, lane); }
            }
        }
        if (bx >= NS5) {
            const int wk = (bx - NS5) * NWAVES + wave, NWK = (G - NS5) * NWAVES;
            LAS float* scr = (LAS float*)(lds + wave * 8448);
            constexpr int XR = 8, NIT = I_IN;
#define P0_ITEM(it_, W_, ldw_, src0_, gk_, WT_, dst0_, k0_) const float* W_; int ldw_, src0_, dst0_, k0_; const float* gk_; bf16_t* WT_; \
            { int r_ = (it_); if (r_ < I_IN) { const int kb = r_ / 48, nb = r_ % 48, n0 = 32 * nb; int sr = n0; if (n0 >= 512) { const int q = (n0 - 512) >> 8, bj = ((n0 - 512) >> 7) & 1, rr = n0 & 127; sr = 512 + 512 * bj + 128 * q + rr; } \
                  W_ = AIN(I_WIN); ldw_ = 1536; src0_ = sr; gk_ = AIN(I_G1); WT_ = WIN; dst0_ = n0; k0_ = 64 * kb; } \
              else { r_ -= I_IN; const int kb = r_ / 32, nb = r_ % 32; W_ = AIN(I_WOUT); ldw_ = 1024; src0_ = 32 * nb; gk_ = nullptr; WT_ = WOUT; dst0_ = 32 * nb; k0_ = 64 * kb; } }
            f32x4 xv[XR][4];
#pragma unroll
            for (int q = 0; q < XR; ++q) { const int row = wk + q * NWK; if (row < NTOK) { const f32x4* xr = (const f32x4*)(AIN(I_X) + (size_t)row * DM) + lane;
#pragma unroll
                for (int j = 0; j < 4; ++j) xv[q][j] = xr[64 * j]; } }
            float tv[32]; float tg = 1.0f;
            const bool has_t = wk < NIT;
            P0_ITEM(has_t ? wk : 0, tW, tldw, tsrc0, tgk, tWT, tdst0, tk0)
            if (has_t) {
#pragma unroll
                for (int i = 0; i < 32; ++i) { const int kk = 2 * i + (lane >> 5); tv[i] = tW[(size_t)(tk0 + kk) * tldw + tsrc0 + (lane & 31)]; }
                tg = tgk ? tgk[tk0 + (lane & 63)] : 1.0f;
            }
            f32x4 qv[8]; float qg = 1.0f;
            const bool has_q = wk < DM;
            if (has_q) { qg = AIN(I_G2)[wk]; const f32x4* wr_ = (const f32x4*)(AIN(I_WQ) + (size_t)wk * NQ) + lane;
#pragma unroll
                for (int j = 0; j < 8; ++j) qv[j] = wr_[64 * j]; }
            if (has_t) {
#pragma unroll
                for (int i = 0; i < 32; ++i) { const int kk = 2 * i + (lane >> 5); scr[kk * 33 + (lane & 31)] = tv[i] * __shfl(tg, kk); }
                LDS_WAIT(); asm volatile("" ::: "memory");
                const int c = lane & 7;
#pragma unroll
                for (int j = 0; j < 4; ++j) { const int n = (lane >> 3) + 8 * j; const LAS float* sp = scr + (8 * c) * 33 + n;
                    u32x4 o; o.x = cvt_pk_bf16(sp[0 * 33], sp[1 * 33]); o.y = cvt_pk_bf16(sp[2 * 33], sp[3 * 33]); o.z = cvt_pk_bf16(sp[4 * 33], sp[5 * 33]); o.w = cvt_pk_bf16(sp[6 * 33], sp[7 * 33]);
                    *(u32x4*)(tWT + (size_t)(tdst0 + n) * DM + tk0 + 8 * c) = o; }
                LDS_WAIT(); asm volatile("" ::: "memory");
            }
            if (has_q) { u32x2* o8 = (u32x2*)(WQB + (size_t)wk * NQ) + lane;
#pragma unroll
                for (int j = 0; j < 8; ++j) { u32x2 w; w.x = cvt_pk_bf16(qv[j][0] * qg, qv[j][1] * qg); w.y = cvt_pk_bf16(qv[j][2] * qg, qv[j][3] * qg); o8[64 * j] = w; } }
#define P0_XFIN(v_, row_) do { float sq = 0.f; _Pragma("unroll") for (int j = 0; j < 4; ++j) sq += (v_[j][0] * v_[j][0] + v_[j][1] * v_[j][1]) + (v_[j][2] * v_[j][2] + v_[j][3] * v_[j][3]); \
                sq = wave_sum_dpp(sq); if (lane == 0) RSTD1[row_] = rsqrtf(sq * (1.0f / DM) + EPS); u32x2* o8 = (u32x2*)(XB + (size_t)(row_) * DM) + lane; \
                _Pragma("unroll") for (int j = 0; j < 4; ++j) { u32x2 w; w.x = cvt_pk_bf16(v_[j][0], v_[j][1]); w.y = cvt_pk_bf16(v_[j][2], v_[j][3]); o8[64 * j] = w; } } while (0)
#pragma unroll
            for (int q = 0; q < XR; ++q) { const int row = wk + q * NWK; if (row < NTOK) P0_XFIN(xv[q], row); }
            for (int it = wk + NWK; it < NIT; it += NWK) { P0_ITEM(it, W2, ldw2, src02, gk2, WT2, dst02, k02) p0_transpose_item(W2, ldw2, src02, gk2, WT2, DM, dst02, k02, scr, lane); }
            for (int row = wk + NWK; row < DM; row += NWK) {
                const float gk = AIN(I_G2)[row];
                const f32x4* wr_ = (const f32x4*)(AIN(I_WQ) + (size_t)row * NQ) + lane; u32x2* o8 = (u32x2*)(WQB + (size_t)row * NQ) + lane;
                f32x4 v[8];
#pragma unroll
                for (int j = 0; j < 8; ++j) v[j] = wr_[64 * j];
#pragma unroll
                for (int j = 0; j < 8; ++j) { u32x2 w; w.x = cvt_pk_bf16(v[j][0] * gk, v[j][1] * gk); w.y = cvt_pk_bf16(v[j][2] * gk, v[j][3] * gk); o8[64 * j] = w; }
            }
            for (int row0 = wk + XR * NWK; row0 < NTOK; row0 += XR * NWK) {
                f32x4 v[XR][4];
#pragma unroll
                for (int q = 0; q < XR; ++q) { const int row = row0 + q * NWK; if (row < NTOK) { const f32x4* xr = (const f32x4*)(AIN(I_X) + (size_t)row * DM) + lane;
#pragma unroll
                    for (int j = 0; j < 4; ++j) v[q][j] = xr[64 * j]; } }
#pragma unroll
                for (int q = 0; q < XR; ++q) { const int row = row0 + q * NWK; if (row < NTOK) P0_XFIN(v[q], row); }
            }
#undef P0_ITEM
#undef P0_XFIN
        }
        {
            const int gt = gw * 64 + lane, NGT = NGW * 64;
            for (int i = gt; i < PO_END; i += NGT) { float v;
                if (i < PO_CB) v = AIN(I_CW)[i]; else if (i < PO_LNG) v = AIN(I_CB)[i - PO_CB]; else if (i < PO_LNB) v = AIN(I_LNG)[i - PO_LNG]; else if (i < PO_GLUW) v = AIN(I_LNB)[i - PO_LNB];
                else if (i < PO_GLUB) v = AIN(I_GLUW)[i - PO_GLUW]; else if (i < PO_G2) v = AIN(I_GLUB)[i - PO_GLUB]; else if (i < PO_FG) v = AIN(I_G2)[i - PO_G2]; else v = AIN(I_FG)[i - PO_FG];
                PAR[i] = v; }
        }
        for (int row = gw; row < 256; row += NGW) {
            const int c4 = lane * 4; float v[4];
#pragma unroll
            for (int e = 0; e < 4; ++e) { const int c = c4 + e; float x = 0.f;
                if (row < 128 && c < 128) x = AIN(I_K1)[row * 128 + c];
                if (row >= 128 && c >= 128) x = AIN(I_K2)[(row - 128) * 128 + (c - 128)];
                v[e] = x; }
            u32x2 w; w.x = cvt_pk_bf16(v[0], v[1]); w.y = cvt_pk_bf16(v[2], v[3]); *(u32x2*)(KBLK + row * 256 + c4) = w;
        }
    } }

    SEAM(0);
    if (IN(1)) { for (int rep_ = 0; rep_ < (((REP_MASK) >> 1) & 1) + 1; ++rep_) { if (rep_) grid_.sync();
        pg8::Gemm g{DM, DM, DM}; pg8::GridOrder S; S.init(XB, WIN, DM, DM, NTOK, 1536, G, bx);
        EpiP1 E{RSTD1, UEXT, HCONV};
        pg8::gemm_phase<EpiP1, pg8::GridOrder, true>(lds, g, S, E, wave0);
        if (bx + G >= 384) {
            for (int w = bx - (384 - G); w < 32; w += 2 * G - 384) {
                __syncthreads();
                const int h = w >> 2, kb4 = w & 3;
                pg8::Gemm gm{256, 256, NQ}; pg8::OneUnit S; S.valid = 1; S.u.pm = h; S.u.pn = kb4;
                S.u.A = (const char*)KBLK; S.u.B = (const char*)(WQB + (size_t)kb4 * 256 * NQ + h * 256);
                EpiWqk E{WQK};
                pg8::gemm_phase<EpiWqk, pg8::OneUnit, false>(lds, gm, S, E, wave0);
                __syncthreads();
            }
            PH_IDS();
            CArgs* pa = ap; asm volatile("" : "+s"(pa));
            constexpr int TWQ = 5632;
            const int sb = bx - (384 - G), nsb = 2 * G - 384;
            const bool wq = sb < 32 && nsb > 32;
            const int TNW = (wq ? 32 : (nsb > 32 ? nsb - 32 : nsb)) * NWAVES, tw = (wq ? sb : (nsb > 32 ? sb - 32 : sb)) * NWAVES + wave;
            const int tbase = wq ? 0 : (nsb > 32 ? TWQ : 0), tlim = wq ? TWQ : 2 * NEXP;
            for (int row0 = tbase + tw; row0 < tlim; row0 += 4 * TNW) {
                f32x4 v[4][4];
#pragma unroll
                for (int q = 0; q < 4; ++q) { const int row = row0 + q * TNW; if (row < tlim) { const float* src = (row < NEXP) ? pa->in[I_U] + (size_t)row * DM : pa->in[I_V] + (size_t)(row - NEXP) * DM; const f32x4* xr = (const f32x4*)src + 4 * lane;
#pragma unroll
                    for (int j = 0; j < 4; ++j) v[q][j] = xr[j]; } }
#pragma unroll
                for (int q = 0; q < 4; ++q) { const int row = row0 + q * TNW; if (row < tlim) {
                    unsigned char* dst = (row < NEXP) ? UTAB + (size_t)row * DM : VTAB + (size_t)(row - NEXP) * DM; float mx = 0.f;
#pragma unroll
                    for (int j = 0; j < 4; ++j) mx = fmaxf(mx, fmaxf(fmaxf(fabsf(v[q][j][0]), fabsf(v[q][j][1])), fmaxf(fabsf(v[q][j][2]), fabsf(v[q][j][3]))));
#pragma unroll
                    for (int o = 1; o < 64; o <<= 1) mx = fmaxf(mx, __shfl_xor(mx, o));
                    const int E = (int)((__builtin_bit_cast(unsigned, mx) >> 23) & 0xFFu);
                    int k = E - 134; k = (E == 0) ? 0 : k; k = k < -100 ? -100 : (k > 100 ? 100 : k);
                    const float sinv = __builtin_bit_cast(float, (unsigned)(127 - k) << 23);
                    u32x4 w;
#pragma unroll
                    for (int j = 0; j < 4; ++j) { int p = 0; p = __builtin_amdgcn_cvt_pk_fp8_f32(v[q][j][0] * sinv, v[q][j][1] * sinv, p, false); p = __builtin_amdgcn_cvt_pk_fp8_f32(v[q][j][2] * sinv, v[q][j][3] * sinv, p, true); w[j] = (unsigned)p; }
                    *((u32x4*)dst + lane) = w;
                    if (lane == 0) { if (row < NEXP) EXPU[row] = k + 128; else EXPV[row - NEXP] = k + 128; } } }
            }
        }
    } }

    SEAM(1);
    if (IN(2)) { for (int rep_ = 0; rep_ < (((REP_MASK) >> 2) & 1) + 1; ++rep_) { if (rep_) grid_.sync();
        constexpr int NCT = NTOK / 32;
        if (bx < 128) {
            const int g = bx >> 2, pn = bx & 3;
            {
                pg8::Gemm gm{256, 256, KX}; pg8::OneUnit S; S.valid = 1; S.u.pm = 0; S.u.pn = pn;
                S.u.A = (const char*)(W1EXT + (size_t)g * 256 * 256); S.u.B = (const char*)(UEXT + ((size_t)g * NCH + pn * 256) * KX);
                EpiScan E{LPOW, UEXT, g, pn};
                pg8::gemm_phase<EpiScan, pg8::OneUnit, false>(lds, gm, S, E, wave0);
            }
            VM_WAIT(); __syncthreads();
            if (T0_()) { __builtin_amdgcn_fence(__ATOMIC_ACQUIRE, "agent"); asm volatile("s_waitcnt vmcnt(0)" ::: "memory"); }
            __syncthreads();
            {
                pg8::Gemm gm{KX, KX, KX}; pg8::OneUnit S; S.valid = 1; S.u.pm = pn; S.u.pn = 0;
                S.u.A = (const char*)(UEXT + ((size_t)g * NCH + pn * 256) * KX); S.u.B = (const char*)(KEXT + (size_t)g * 256 * KX);
                EpiGlu E{PAR + PO_GLUW, PAR + PO_GLUB, YCAT, g, pn};
                pg8::gemm_phase<EpiGlu, pg8::OneUnit, false>(lds, gm, S, E, wave0);
            }
            __syncthreads();
            conv_tiles<32>(lds, PAR, HCONV, YCAT, bx, bx + 1, 1, wave0);
        } else {
            const int nb = G - 128, per = (NCT - 128 + nb - 1) / nb, f0 = 128 + (bx - 128) * per, f1 = (f0 + per) < NCT ? (f0 + per) : NCT;
            conv_tiles<32>(lds, PAR, HCONV, YCAT, f0, f1, 1, wave0);
        }
    } }

    SEAM(3);
    if (IN(4)) { for (int rep_ = 0; rep_ < (((REP_MASK) >> 4) & 1) + 1; ++rep_) { if (rep_) grid_.sync();
        pg8::Gemm g{DM, DM, DM}; pg8::GridOrder S; S.init(YCAT, WOUT, DM, DM, NTOK, DM, G, bx);
        CArgs* pa = ap; asm volatile("" : "+s"(pa));
        EpiRes E{pa->in[I_X], X1, XB, SSQ2};
        pg8::gemm_phase<EpiRes, pg8::GridOrder, true>(lds, g, S, E, wave0);
    } }

    SEAM(4);
    if (IN(5)) { {
        pg8::GridOrder S5o; S5o.init(XB, WQK, DM, DM, NTOK, NQ, G, bx);
        LAS float* RSV = (LAS float*)(lds + 150016);
        { PH_IDS();
          for (int idx = tid; idx < 4 * 256; idx += NTHR) { pg8::Unit uu; if (S5o.next(idx >> 8, uu)) {
              const f32x4* sp = (const f32x4*)(SSQ2 + (size_t)(uu.pm * 256 + (idx & 255)) * 16); const f32x4 s0 = sp[0], s1 = sp[1], s2 = sp[2], s3 = sp[3];
              const float ssum = ((s0[0] + s0[1]) + (s0[2] + s0[3])) + ((s1[0] + s1[1]) + (s1[2] + s1[3])) + ((s2[0] + s2[1]) + (s2[2] + s2[3])) + ((s3[0] + s3[1]) + (s3[2] + s3[3]));
              RSV[idx] = rsqrtf(ssum * (1.0f / DM) + EPS); } }
          LDS_WAIT(); __syncthreads(); }
        for (int i = 0; ; ++i) {
            pg8::OneUnit S; S.valid = 1; if (!S5o.next(i, S.u)) break;
            pg8::Gemm gm{DM, DM, DM};
            EpiTopk E{RSV + 256 * (i & 3), SELE, SELG};
            pg8::gemm_phase<EpiTopk, pg8::OneUnit, false>(lds, gm, S, E, wave0);
            __syncthreads();
        }
    } }

    SEAM(6);
    if (IN(7)) { for (int rep_ = 0; rep_ < (((REP_MASK) >> 7) & 1) + 1; ++rep_) { if (rep_) { __syncthreads(); }
        PH_IDS();
        constexpr int TPW = 8, SHU = 11, NSLABU = NEXP >> SHU, RS = 16, NIT = TPW * 128, ROWB = 1024, USLOT = 1056, NGRP = NIT / 8;
        LAS unsigned char* WL = lds + wave * 20480;
        LAS unsigned short* ORD = (LAS unsigned short*)WL;
        LAS unsigned char* OWN = WL + 2048;
        LAS unsigned char* RINGU = WL + 3072;
        LAS unsigned char* RING = WL + 3072;
        LAS float* DOT = (LAS float*)(WL + 3072);
#define G_WAITV(n) asm volatile("s_waitcnt vmcnt(" #n ")" ::: "memory")
        for (int tg = gw; tg < NTOK / TPW; tg += NGW) {
            int lane; asm volatile("v_mbcnt_lo_u32_b32 %0, -1, 0\n\tv_mbcnt_hi_u32_b32 %0, -1, %0" : "=&v"(lane));
            const int t0 = tg * TPW;
            int e_lo[TPW], e_hi[TPW], kx[TPW];
            {
                const f32x4* gr = (const f32x4*)(PAR + PO_G2) + 4 * lane;
                const f32x4 g2a = gr[0], g2b = gr[1], g2c = gr[2], g2d = gr[3];
#pragma unroll
                for (int i = 0; i < TPW; ++i) {
                    const int tok = t0 + i;
                    const u32x4* xr = (const u32x4*)(XB + (size_t)tok * DM) + 2 * lane;
                    const u32x4 xa = xr[0], xb = xr[1];
                    const f32x4 a0 = (f32x4){bf2f(xa[0] & 0xFFFFu), bf2f(xa[0] >> 16), bf2f(xa[1] & 0xFFFFu), bf2f(xa[1] >> 16)}, a1 = (f32x4){bf2f(xa[2] & 0xFFFFu), bf2f(xa[2] >> 16), bf2f(xa[3] & 0xFFFFu), bf2f(xa[3] >> 16)};
                    const f32x4 a2 = (f32x4){bf2f(xb[0] & 0xFFFFu), bf2f(xb[0] >> 16), bf2f(xb[1] & 0xFFFFu), bf2f(xb[1] >> 16)}, a3 = (f32x4){bf2f(xb[2] & 0xFFFFu), bf2f(xb[2] >> 16), bf2f(xb[3] & 0xFFFFu), bf2f(xb[3] >> 16)};
                    float ps = (lane < 16) ? SSQ2[(size_t)tok * 16 + lane] : 0.f; ps = wave_sum_dpp(ps);
                    const float rs = rsqrtf(ps * (1.0f / DM) + EPS);
                    f32x4 b[4]; b[0] = a0 * g2a * rs; b[1] = a1 * g2b * rs; b[2] = a2 * g2c * rs; b[3] = a3 * g2d * rs;
                    float mx = 0.f;
#pragma unroll
                    for (int j = 0; j < 4; ++j) mx = fmaxf(mx, fmaxf(fmaxf(fabsf(b[j][0]), fabsf(b[j][1])), fmaxf(fabsf(b[j][2]), fabsf(b[j][3]))));
                    mx = wave_max_dpp(mx);
                    const int E = (int)((__builtin_bit_cast(unsigned, mx) >> 23) & 0xFFu);
                    int k = E - 134; k = (E == 0) ? 0 : k; k = k < -100 ? -100 : (k > 100 ? 100 : k);
                    kx[i] = __builtin_amdgcn_readfirstlane(k);
                    const float sinv = __builtin_bit_cast(float, (unsigned)(127 - k) << 23);
                    u32x4 wq;
#pragma unroll
                    for (int j = 0; j < 4; ++j) { int p = 0; p = __builtin_amdgcn_cvt_pk_fp8_f32(b[j][0] * sinv, b[j][1] * sinv, p, false); p = __builtin_amdgcn_cvt_pk_fp8_f32(b[j][2] * sinv, b[j][3] * sinv, p, true); wq[j] = (unsigned)p; }
                    *(LAS u32x4*)(RINGU + i * 1024 + lane * 16) = wq;
                    e_lo[i] = SELE[(size_t)tok * 128 + lane]; e_hi[i] = SELE[(size_t)tok * 128 + 64 + lane];
                }
            }
            int p_lo[TPW], p_hi[TPW];
            {
                int running = 0;
                int xu_lo[TPW], xv_lo[TPW], xu_hi[TPW], xv_hi[TPW];
#pragma unroll
                for (int i = 0; i < TPW; ++i) { xu_lo[i] = EXPU[e_lo[i]]; xv_lo[i] = EXPV[e_lo[i]]; xu_hi[i] = EXPU[e_hi[i]]; xv_hi[i] = EXPV[e_hi[i]]; p_lo[i] = 0; p_hi[i] = 0; }
                for (int sl = 0; sl < NSLABU; ++sl) {
#pragma unroll
                    for (int i = 0; i < TPW; ++i) {
                        const int ls = (e_lo[i] & 0x3FFF) >> SHU, hs = (e_hi[i] & 0x3FFF) >> SHU;
                        const unsigned long long ml = __ballot(ls == sl), mh = __ballot(hs == sl);
                        const int cl = __popcll(ml);
                        const int rl = (int)__builtin_amdgcn_mbcnt_hi((unsigned)(ml >> 32), __builtin_amdgcn_mbcnt_lo((unsigned)ml, 0u)), rh = (int)__builtin_amdgcn_mbcnt_hi((unsigned)(mh >> 32), __builtin_amdgcn_mbcnt_lo((unsigned)mh, 0u));
                        p_lo[i] = (ls == sl) ? running + rl : p_lo[i]; p_hi[i] = (hs == sl) ? running + cl + rh : p_hi[i];
                        running += cl + __popcll(mh);
                    }
                }
#pragma unroll
                for (int i = 0; i < TPW; ++i) { ORD[p_lo[i]] = (unsigned short)(e_lo[i] & 0x3FFF); OWN[p_lo[i]] = (unsigned char)i; ORD[p_hi[i]] = (unsigned short)(e_hi[i] & 0x3FFF); OWN[p_hi[i]] = (unsigned char)i; }
#pragma unroll
                for (int i = 0; i < TPW; ++i) { e_lo[i] |= (xu_lo[i] << 14) | (xv_lo[i] << 22); e_hi[i] |= (xu_hi[i] << 14) | (xv_hi[i] << 22); asm volatile("" : "+v"(e_lo[i]), "+v"(e_hi[i])); }
            }
            VM_WAIT(); LDS_WAIT(); asm volatile("" ::: "memory");
            {
                int lane_u = lane; asm volatile("" : "+v"(lane_u));
                const int mq = lane_u & 15, q = lane_u >> 4;
                const int chq = 16 * (q & 1) + 8 * (q >> 1);
                i32x8 Bx[2][4];
#pragma unroll
                for (int hh = 0; hh < 2; ++hh)
#pragma unroll
                    for (int st = 0; st < 4; ++st) {
                        const LAS unsigned char* xp = RINGU + (mq & 7) * 1024 + 512 * hh + 16 * (chq + 2 * st);
                        const i32x4 b0 = *(const LAS i32x4*)xp, b1 = *(const LAS i32x4*)(xp + 16);
                        Bx[hh][st] = (i32x8){b0[0], b0[1], b0[2], b0[3], b1[0], b1[1], b1[2], b1[3]};
                    }
                asm volatile("s_waitcnt lgkmcnt(0)" ::: "memory");
                const int ab = (mq >> 1) * USLOT + 512 * (mq & 1) + 16 * (chq + (mq & 1));
                const int ab7 = ab + 112 - ((q == 3 && (mq & 1)) ? 512 : 0);
                const unsigned srcoffu0 = 16u * (unsigned)(((lane_u & 31) - (lane_u >> 5)) & 31);
                LAS float* STG = (LAS float*)(WL + 19968);
                float dflat[16];
#pragma unroll
                for (int r = 0; r < 16; ++r) dflat[r] = 0.f;
                const LAS unsigned short* ordl = ORD + (lane_u >> 5);
#define U_LIST(EV_, G_) do { const int gq_ = (G_) < 64 ? (G_) : (hh == 0 ? (G_) - 64 : 63); _Pragma("unroll") for (int k_ = 0; k_ < 8; ++k_) EV_[k_] = ordl[16 * gq_ + 2 * k_]; } while (0)
#define U_LOADS(EV_, HALF_, SO_) do { const unsigned so_ = (SO_); _Pragma("unroll") for (int k_ = 0; k_ < 8; ++k_) { const unsigned off_ = ((unsigned)EV_[k_] << 10) | so_; \
                    __builtin_amdgcn_global_load_lds((const unsigned*)(UTAB + off_), (LAS unsigned*)(RINGU + (8 * (HALF_) + k_) * USLOT), 16, 0, 0); } } while (0)
#pragma unroll
                for (int hh = 0; hh < 2; ++hh) {
                    const unsigned srcoffu = srcoffu0 + 512u * (unsigned)hh;
                    if (hh == 0) { VM_WAIT();
                        unsigned short ev0[8], ev1[8]; U_LIST(ev0, 0); U_LIST(ev1, 1); LDS_WAIT(); U_LOADS(ev0, 0, srcoffu); U_LOADS(ev1, 1, srcoffu); }
#pragma unroll
                    for (int r = 0; r < 16; ++r) {
                        for (int gg = 0; gg < 4; ++gg) {
                            const int G = 4 * r + gg;
                            unsigned short ev[8]; U_LIST(ev, G + 2);
                            const unsigned own4 = *(const LAS unsigned*)(OWN + 16 * G + 4 * q);
                            G_WAITV(8);
                            const LAS unsigned char* rbu = RINGU + (gg & 1) * (8 * USLOT);
                            i32x8 A[4];
#pragma unroll
                            for (int st = 0; st < 4; ++st) {
                                const i32x4 a0 = *(const LAS i32x4*)(rbu + ab + 32 * st), a1 = (st < 3) ? *(const LAS i32x4*)(rbu + ab + 32 * st + 16) : *(const LAS i32x4*)(rbu + ab7);
                                A[st] = (i32x8){a0[0], a0[1], a0[2], a0[3], a1[0], a1[1], a1[2], a1[3]};
                            }
                            LDS_WAIT();
                            U_LOADS(ev, gg & 1, (hh == 0 && G + 2 >= 64) ? srcoffu0 + 512u : srcoffu);
                            f32x4 acc4 = (f32x4){0.f, 0.f, 0.f, 0.f};
#pragma unroll
                            for (int st = 0; st < 4; ++st) acc4 = __builtin_amdgcn_mfma_scale_f32_16x16x128_f8f6f4(A[st], Bx[hh][st], acc4, 0, 0, 0, 0x7F7F7F7F, 0, 0x7F7F7F7F);
#pragma unroll
                            for (int j = 0; j < 4; ++j) {
                                const float accj = acc4[j];
                                if ((int)((own4 >> (8 * j)) & 0xFFu) == mq) STG[16 * gg + 4 * q + j] = accj;
                            }
                        }
                        LDS_WAIT();
                        dflat[r] += STG[lane_u];
                    }
                }
#undef U_LIST
#undef U_LOADS
                VM_WAIT();
#pragma unroll
                for (int r = 0; r < 16; ++r) DOT[64 * r + lane] = dflat[r];
                LDS_WAIT(); asm volatile("" ::: "memory");
            }
            float w_lo[TPW], w_hi[TPW];
            {
#pragma unroll
                for (int i = 0; i < TPW; ++i) {
                    const int tok = t0 + i;
                    const float slo = __builtin_bit_cast(float, (unsigned)(((e_lo[i] >> 14) & 0xFF) + kx[i] - 1) << 23), shi = __builtin_bit_cast(float, (unsigned)(((e_hi[i] >> 14) & 0xFF) + kx[i] - 1) << 23);
                    const f32x2 ge = gelu_pk((f32x2){DOT[p_lo[i]] * slo, DOT[p_hi[i]] * shi});
                    w_lo[i] = SELG[(size_t)tok * 128 + lane] * ge.x; w_hi[i] = SELG[(size_t)tok * 128 + 64 + lane] * ge.y;
                }
            }
            unsigned ORDR[8];
#pragma unroll
            for (int v = 0; v < 8; ++v) ORDR[v] = ((const LAS unsigned*)ORD)[64 * v + lane];
            LDS_WAIT(); asm volatile("" ::: "memory");
            LAS unsigned char* WQ = WL;
            int kw[TPW];
#pragma unroll
            for (int i = 0; i < TPW; ++i) {
                const float sl_ = __builtin_bit_cast(float, (unsigned)(((e_lo[i] >> 22) & 0xFF) - 1) << 23), sh_ = __builtin_bit_cast(float, (unsigned)(((e_hi[i] >> 22) & 0xFF) - 1) << 23);
                const float wl = w_lo[i] * sl_, wh = w_hi[i] * sh_;
                float mx = fmaxf(fabsf(wl), fabsf(wh));
                mx = wave_max_dpp(mx);
                const int E = (int)((__builtin_bit_cast(unsigned, mx) >> 23) & 0xFFu);
                int k = E - 134; k = (E == 0) ? 0 : k; k = k < -100 ? -100 : (k > 100 ? 100 : k);
                kw[i] = __builtin_amdgcn_readfirstlane(k);
                const float sinv = __builtin_bit_cast(float, (unsigned)(127 - k) << 23);
                const float al = wl * sinv, ah = wh * sinv;
                const int ph = __builtin_amdgcn_cvt_pk_fp8_f32(al, ah, 0, false);
                const float fl = __builtin_amdgcn_cvt_f32_fp8(ph, 0), fh = __builtin_amdgcn_cvt_f32_fp8(ph, 1);
                const int pl = __builtin_amdgcn_cvt_pk_fp8_f32(al - fl, ah - fh, 0, false);
                WQ[p_lo[i]] = (unsigned char)(ph & 0xFF); WQ[p_hi[i]] = (unsigned char)((ph >> 8) & 0xFF);
                WQ[1024 + p_lo[i]] = (unsigned char)(pl & 0xFF); WQ[1024 + p_hi[i]] = (unsigned char)((pl >> 8) & 0xFF);
            }
            VM_WAIT(); LDS_WAIT(); asm volatile("" ::: "memory");
            {
                int lane_v = lane; asm volatile("" : "+v"(lane_v));
                const int nq = lane_v & 15, kq = lane_v >> 4;
                const int rho = 8 * (kq & 1) + (nq >> 1), hb = rho & 1;
                const int lb = (rho >> 1) * USLOT + 528 * hb + 8 * (nq & 1);
                const int lb31 = lb + 496 - 512 * hb;
                const unsigned srcoff0 = 16u * (unsigned)(((lane_v & 31) - (lane_v >> 5)) & 31);
                const unsigned shv = 16u * (unsigned)(lane_v >> 5);
                float tsc = 0.f;
#pragma unroll
                for (int i = 0; i < TPW; ++i) tsc = ((nq & 7) == i) ? __builtin_bit_cast(float, (unsigned)(127 + kw[i]) << 23) : tsc;
                const unsigned long long nrep = 0x0101010101010101ull * (unsigned long long)nq;
                const int wqoff = ((kq & 2) ? 1024 : 0) + 8 * (kq & 1);
                float ssq = 0.f;
                u32x2 stash[16];
                float* x1p = X1; asm volatile("" : "+s"(x1p));
                const bf16_t* xbp = XB; asm volatile("" : "+s"(xbp));
                const float* par2 = PAR; asm volatile("" : "+s"(par2));
#define V_ISSUE(SRC_, L0_, HALF_, SO_) do { const int l0_ = (L0_); const unsigned so_ = (SO_); \
                _Pragma("unroll") for (int k_ = 0; k_ < 8; ++k_) { const unsigned wd_ = (unsigned)__builtin_amdgcn_readlane((int)(SRC_), l0_ + k_); \
                    const unsigned off_ = (__builtin_amdgcn_ubfe(wd_, shv, 16) << 10) | so_; \
                    __builtin_amdgcn_global_load_lds((const unsigned*)(VTAB + off_), (LAS unsigned*)(RINGU + (8 * (HALF_) + k_) * USLOT), 16, 0, 0); } } while (0)
                for (int h = 0; h < 2; ++h) {
                    const unsigned srcoff = srcoff0 + 512u * (unsigned)h;
                    f32x4 acc[32];
#pragma unroll
                    for (int T = 0; T < 32; ++T) acc[T] = (f32x4){0.f, 0.f, 0.f, 0.f};
                    if (h == 0) { VM_WAIT(); V_ISSUE(ORDR[0], 0, 0, srcoff); V_ISSUE(ORDR[0], 8, 1, srcoff); }
#pragma unroll
                    for (int v = 0; v < 8; ++v) {
                        for (int j = 0; j < 8; ++j) {
                            const int b = 8 * v + j;
                            G_WAITV(8);
                            const LAS unsigned char* rb = RINGU + (j & 1) * (8 * USLOT);
#define V_READ8(A_, tb_) do { _Pragma("unroll") for (int T = 0; T < 8; ++T) A_[T] = __builtin_bit_cast(long, __builtin_amdgcn_ds_read_tr8_b64_v2i32((LAS i32x2*)((8 * (tb_) + T) < 31 ? rb + lb + 16 * (8 * (tb_) + T) : rb + lb31))); } while (0)
                            long A[8];
                            V_READ8(A, 0);
                            const unsigned long long wq = *(const LAS unsigned long long*)(WQ + wqoff + 16 * b);
                            const unsigned long long ow = *(const LAS unsigned long long*)(OWN + 8 * (kq & 1) + 16 * b);
                            const unsigned long long xo = ow ^ nrep;
                            const unsigned x0 = (unsigned)xo, x1 = (unsigned)(xo >> 32);
                            const unsigned n0 = (x0 + 0x7F7F7F7Fu) & 0x80808080u, n1 = (x1 + 0x7F7F7F7Fu) & 0x80808080u;
                            const unsigned m0 = n0 | (n0 - (n0 >> 7)), m1 = n1 | (n1 - (n1 >> 7));
                            const long B = (long)(((unsigned long long)((unsigned)(wq >> 32) & ~m1) << 32) | (unsigned long long)((unsigned)wq & ~m0));
#pragma unroll
                            for (int tb = 0; tb < 4; ++tb) {
                                if (tb > 0) V_READ8(A, tb);
                                if (tb == 3) {
                                    LDS_WAIT();
                                    const bool last = (v == 7) && (j >= 6), wrap = last && (h == 0);
                                    const unsigned src = wrap ? ORDR[0] : ((j < 6 || v == 7) ? ORDR[v] : ORDR[v < 7 ? v + 1 : 7]);
                                    V_ISSUE(src, wrap ? 8 * (j - 6) : (last ? 56 : ((8 * (j + 2)) & 63)), j & 1, wrap ? srcoff0 + 512u : srcoff);
                                }
#pragma unroll
                                for (int T = 0; T < 8; ++T) acc[8 * tb + T] = __builtin_amdgcn_mfma_f32_16x16x32_fp8_fp8(A[T], B, acc[8 * tb + T], 0, 0, 0);
                            }
#undef V_READ8
                        }
                    }
                    {
                        const int tok = t0 + (nq & 7);
                        const int cofs = 16 * (nq >> 3) + 4 * kq;
                        const bf16_t* xrow = xbp + (size_t)tok * DM + 512 * h + cofs;
#pragma unroll
                        for (int t = 0; t < 16; ++t) {
                            f32x4 mg;
#pragma unroll
                            for (int r = 0; r < 4; ++r) { const float ev = acc[2 * t][r], od = acc[2 * t + 1][r];
                                mg[r] = __builtin_bit_cast(float, __builtin_amdgcn_update_dpp(__builtin_bit_cast(int, ev), __builtin_bit_cast(int, od), 0x128, 0xF, 0xC, false)); }
                            const u32x2 xq = *(const u32x2*)(xrow + 32 * t);
                            const f32x4 o = (f32x4){bf2f(xq.x & 0xFFFFu), bf2f(xq.x >> 16), bf2f(xq.y & 0xFFFFu), bf2f(xq.y >> 16)} + mg * tsc;
                            ssq += (o[0] * o[0] + o[1] * o[1]) + (o[2] * o[2] + o[3] * o[3]);
                            acc[2 * t] = o;
                            if ((t & 3) == 3) asm volatile("" ::: "memory");
                        }
                        if (h == 0) {
#pragma unroll
                            for (int t = 0; t < 16; ++t) { stash[t].x = cvt_pk_bf16_c(acc[2 * t][0], acc[2 * t][1]); stash[t].y = cvt_pk_bf16_c(acc[2 * t][2], acc[2 * t][3]); }
                        } else {
                            float tot = 0.f;
#pragma unroll
                            for (int i = 0; i < TPW; ++i) { const float ti = wave_sum_dpp(((nq & 7) == i) ? ssq : 0.f); tot = ((nq & 7) == i) ? ti : tot; }
                            const float rf = rsqrtf(tot * (1.0f / DM) + EPS);
                            float* orow = x1p + (size_t)tok * DM + cofs;
                            const float* fgp = par2 + PO_FG + cofs;
                            {
                                f32x4 g0[16];
#pragma unroll
                                for (int t = 0; t < 16; ++t) g0[t] = *(const f32x4*)(fgp + 32 * t);
                                asm volatile("" ::: "memory");
#pragma unroll
                                for (int t = 0; t < 16; ++t) {
                                    const f32x4 o0 = (f32x4){bf2f(stash[t].x & 0xFFFFu), bf2f(stash[t].x >> 16), bf2f(stash[t].y & 0xFFFFu), bf2f(stash[t].y >> 16)};
                                    *(f32x4*)(orow + 32 * t) = o0 * rf * g0[t];
                                }
                                asm volatile("" ::: "memory");
                            }
                            {
                                f32x4 g1[16];
#pragma unroll
                                for (int t = 0; t < 16; ++t) g1[t] = *(const f32x4*)(fgp + 512 + 32 * t);
                                asm volatile("" ::: "memory");
#pragma unroll
                                for (int t = 0; t < 16; ++t) *(f32x4*)(orow + 512 + 32 * t) = acc[2 * t] * rf * g1[t];
                            }
                        }
                    }
                }
#undef V_ISSUE
            }
        }
        VM_WAIT();
#undef G_WAITV
    } }
#undef IN
}

extern "C" void kernel_launch(void* const* d_in, const int* in_sizes, int n_in, void* d_out, int out_size, void* d_ws, size_t ws_size, hipStream_t stream) {
    static int grid = 0;
    if (grid == 0) {
        if (n_in != 25 || out_size != NTOK * DM || ws_size < WS_END) { fprintf(stderr, "kernel_launch: unexpected shapes (n_in %d, out %d, ws %zu)\n", n_in, out_size, ws_size); grid = -1; return; }
        int dev = 0, cus = 0;
        if (hipGetDevice(&dev) != hipSuccess || hipDeviceGetAttribute(&cus, hipDeviceAttributeMultiprocessorCount, dev) != hipSuccess) { grid = -1; return; }
        if (hipFuncSetAttribute((const void*)fwd_kernel, hipFuncAttributeMaxDynamicSharedMemorySize, LDS_BYTES) != hipSuccess) { fprintf(stderr, "kernel_launch: hipFuncSetAttribute failed\n"); grid = -1; return; }
        int per_cu = 0;
        if (hipOccupancyMaxActiveBlocksPerMultiprocessor(&per_cu, (const void*)fwd_kernel, NTHR, LDS_BYTES) != hipSuccess || per_cu < 1) { fprintf(stderr, "kernel_launch: occupancy query failed (%d)\n", per_cu); grid = -1; return; }
        grid = cus;
    }
    if (grid < 0) return;
    Args a{};
    for (int i = 0; i < 25; ++i) a.in[i] = (const float*)d_in[i];
    a.out = (float*)d_out; a.ws = (unsigned char*)d_ws;
    a.ph_lo = 0; a.ph_hi = 8;
    if (hipMemsetAsync((char*)d_ws + WS_CTL, 0, 32768, stream) != hipSuccess) { fprintf(stderr, "kernel_launch: memset of the barrier words failed\n"); return; }
    void* kargs[] = {&a};
    hipError_t e = hipLaunchCooperativeKernel((const void*)fwd_kernel, dim3(grid), dim3(NTHR), kargs, LDS_BYTES, stream);
    if (e != hipSuccess) fprintf(stderr, "kernel_launch: cooperative launch failed: %s (grid %d)\n", hipGetErrorString(e), grid);
}
```
